# Optimizing an MI355X kernel written in HIP

```python
import math
import jax, jax.numpy as jnp
from jax import lax
import numpy as np

D_MODEL = 1024
BATCH = 4
SEQ = 4096
DEPTH = 2

GRID_W = 64
CTX_LEN = 256
HEAD_DIM = 64
N_Q_HEADS = 8
N_KV_HEADS = 2
Q_PER_KV = N_Q_HEADS // N_KV_HEADS
ATTN_WIDTH = N_Q_HEADS * HEAD_DIM
KV_WIDTH = N_KV_HEADS * HEAD_DIM
N_FOURIER_GROUPS = 8
FOURIER_GROUP_DIM = 64
FOURIER_WIDTH = N_FOURIER_GROUPS * FOURIER_GROUP_DIM
MIX_WIDTH = ATTN_WIDTH + FOURIER_WIDTH
IN_WIDTH = ATTN_WIDTH + 2 * KV_WIDTH + FOURIER_WIDTH
WINDOW = 128
BLOCK = 128
FFN_HIDDEN = -(-8 * D_MODEL // (3 * 256)) * 256
ROPE_THETA = 10000.0
ROPE_PAIRS_PER_AXIS = HEAD_DIM // 4
RMS_EPS = 1e-6
N_MOD = 6
NEG_INF = -1e30

kernel_name = 'hybrid_fourier_windowed_gqa_dit_block'


def rmsnorm(x, g):
    xf = x.astype(jnp.float32)
    y = xf * lax.rsqrt(jnp.mean(xf * xf, axis=-1, keepdims=True) + RMS_EPS)
    return (y * g.astype(jnp.float32)).astype(x.dtype)


def modulate(h, shift, scale):
    return h * (1.0 + scale) + shift


def axial_rope_tables(rows):
    row = jnp.broadcast_to(jnp.arange(rows)[:, None], (rows, GRID_W)).reshape(-1).astype(jnp.float32)
    col = jnp.broadcast_to(jnp.arange(GRID_W)[None, :], (rows, GRID_W)).reshape(-1).astype(jnp.float32)
    freqs = ROPE_THETA ** (-jnp.arange(ROPE_PAIRS_PER_AXIS, dtype=jnp.float32) / ROPE_PAIRS_PER_AXIS)
    ang = jnp.concatenate([row[:, None] * freqs, col[:, None] * freqs], axis=-1)
    return jnp.cos(ang), jnp.sin(ang)


def apply_axial_rope(x, cos, sin):
    xf = x.astype(jnp.float32).reshape(*x.shape[:-1], HEAD_DIM // 2, 2)
    x1, x2 = xf[..., 0], xf[..., 1]
    c = cos[None, :, None, :]
    s = sin[None, :, None, :]
    out = jnp.stack([x1 * c - x2 * s, x1 * s + x2 * c], axis=-1).reshape(x.shape)
    return out.astype(x.dtype)


def sink_column(sink, lead_shape):
    sk = sink.astype(jnp.float32).reshape(N_KV_HEADS, Q_PER_KV)[:, :, None, None]
    return jnp.broadcast_to(sk, lead_shape + (1,))


def windowed_gqa_with_context(q, k, v, kc, vc, sink):
    B, S = q.shape[0], q.shape[1]
    nb = S // BLOCK
    scale = HEAD_DIM ** -0.5
    qb = q.reshape(B, nb, BLOCK, N_KV_HEADS, Q_PER_KV, HEAD_DIM)
    pad = ((0, 0), (BLOCK, BLOCK), (0, 0), (0, 0))
    kp = jnp.pad(k, pad).reshape(B, nb + 2, BLOCK, N_KV_HEADS, HEAD_DIM)
    vp = jnp.pad(v, pad).reshape(B, nb + 2, BLOCK, N_KV_HEADS, HEAD_DIM)
    kb = jnp.concatenate([kp[:, :-2], kp[:, 1:-1], kp[:, 2:]], axis=2)
    vb = jnp.concatenate([vp[:, :-2], vp[:, 1:-1], vp[:, 2:]], axis=2)
    s_loc = jnp.einsum('bnqkgd,bnjkd->bnkgqj', qb, kb).astype(jnp.float32) * scale
    q_pos = jnp.arange(nb)[:, None] * BLOCK + jnp.arange(BLOCK)[None, :]
    k_pos = (jnp.arange(nb)[:, None] - 1) * BLOCK + jnp.arange(3 * BLOCK)[None, :]
    valid = (jnp.abs(q_pos[:, :, None] - k_pos[:, None, :]) <= WINDOW) & (k_pos[:, None, :] >= 0) & (k_pos[:, None, :] < S)
    s_loc = jnp.where(valid[None, :, None, None], s_loc, NEG_INF)
    s_ctx = jnp.einsum('bnqkgd,bckd->bnkgqc', qb, kc).astype(jnp.float32) * scale
    logits = jnp.concatenate([s_loc, s_ctx, sink_column(sink, s_loc.shape[:-1])], axis=-1)
    p = jax.nn.softmax(logits, axis=-1)
    n_loc = 3 * BLOCK
    n_ctx = kc.shape[1]
    p_loc = p[..., :n_loc].astype(v.dtype)
    p_ctx = p[..., n_loc:n_loc + n_ctx].astype(v.dtype)
    out = jnp.einsum('bnkgqj,bnjkd->bnqkgd', p_loc, vb) + jnp.einsum('bnkgqc,bckd->bnqkgd', p_ctx, vc)
    return out.reshape(B, S, ATTN_WIDTH)


def context_gqa(qc, kc, vc, sink):
    B, C = qc.shape[0], qc.shape[1]
    scale = HEAD_DIM ** -0.5
    qg = qc.reshape(B, C, N_KV_HEADS, Q_PER_KV, HEAD_DIM)
    s = jnp.einsum('bqkgd,bckd->bkgqc', qg, kc).astype(jnp.float32) * scale
    p = jax.nn.softmax(jnp.concatenate([s, sink_column(sink, s.shape[:-1])], axis=-1), axis=-1)[..., :C]
    out = jnp.einsum('bkgqc,bckd->bqkgd', p.astype(vc.dtype), vc)
    return out.reshape(B, C, ATTN_WIDTH)


def fourier_mix(u, w_four):
    B, N = u.shape[0], u.shape[1]
    ug = u.reshape(B, N, N_FOURIER_GROUPS, FOURIER_GROUP_DIM).astype(jnp.float32)
    mixed = jnp.fft.fft2(ug, axes=(1, 3), norm='ortho').real.astype(u.dtype)
    return jnp.einsum('bngc,gcd->bngd', mixed, w_four).reshape(B, N, FOURIER_WIDTH)


def swiglu(h, w_gate, w_up, w_down):
    return (jax.nn.silu(h @ w_gate) * (h @ w_up)) @ w_down


def setup_inputs(seed: int = 0) -> dict:
    key = jax.random.key(seed)
    ks = jax.random.split(key, 17)
    f32 = jnp.float32
    D = D_MODEL

    def nrm(k, shape, s):
        return jax.random.normal(k, shape, f32) * s

    return {
        'x': nrm(ks[0], (BATCH, SEQ, D), 1.0),
        'c': nrm(ks[1], (BATCH, D), 1.0),
        'ctx': nrm(ks[2], (BATCH, CTX_LEN, D), 1.0),
        'c_ctx': nrm(ks[3], (D,), 1.0),
        'w_ada': nrm(ks[4], (DEPTH, D, N_MOD * D), 0.5 * D ** -0.5),
        'b_ada': nrm(ks[5], (DEPTH, N_MOD * D), 0.02),
        'norm_pre_mix': 1.0 + nrm(ks[6], (DEPTH, D), 0.05),
        'norm_post_mix': 1.0 + nrm(ks[7], (DEPTH, D), 0.05),
        'norm_pre_ffn': 1.0 + nrm(ks[8], (DEPTH, D), 0.05),
        'norm_post_ffn': 1.0 + nrm(ks[9], (DEPTH, D), 0.05),
        'w_in': nrm(ks[10], (DEPTH, D, IN_WIDTH), D ** -0.5),
        'w_out': nrm(ks[11], (DEPTH, MIX_WIDTH, D), MIX_WIDTH ** -0.5),
        'w_fourier': nrm(ks[12], (DEPTH, N_FOURIER_GROUPS, FOURIER_GROUP_DIM, FOURIER_GROUP_DIM), FOURIER_GROUP_DIM ** -0.5),
        'sink': nrm(ks[13], (DEPTH, N_Q_HEADS), 0.5),
        'w_gate': nrm(ks[14], (DEPTH, D, FFN_HIDDEN), D ** -0.5),
        'w_up': nrm(ks[15], (DEPTH, D, FFN_HIDDEN), D ** -0.5),
        'w_down': nrm(ks[16], (DEPTH, FFN_HIDDEN, D), FFN_HIDDEN ** -0.5),
    }


def reference(x, c, ctx, c_ctx, w_ada, b_ada, norm_pre_mix, norm_post_mix, norm_pre_ffn, norm_post_ffn,
              w_in, w_out, w_fourier, sink, w_gate, w_up, w_down):
    B, S, D = x.shape
    ROWS = S // GRID_W
    cos, sin = axial_rope_tables(ROWS)
    xc = ctx
    kv_lo, kv_hi = ATTN_WIDTH, ATTN_WIDTH + 2 * KV_WIDTH
    for i in range(DEPTH):
        update_ctx = i < DEPTH - 1
        mod_lat = jax.nn.silu(c) @ w_ada[i] + b_ada[i]
        mod_ctx = jax.nn.silu(c_ctx) @ w_ada[i] + b_ada[i]
        sh1, sc1, g1, sh2, sc2, g2 = [m[:, None, :] for m in jnp.split(mod_lat, N_MOD, axis=-1)]
        csh1, csc1, cg1, csh2, csc2, cg2 = jnp.split(mod_ctx, N_MOD, axis=-1)

        h = modulate(rmsnorm(x, norm_pre_mix[i]), sh1, sc1)
        hc = modulate(rmsnorm(xc, norm_pre_mix[i]), csh1, csc1)
        p = h @ w_in[i]
        q = apply_axial_rope(p[..., :ATTN_WIDTH].reshape(B, S, N_Q_HEADS, HEAD_DIM), cos, sin)
        k = apply_axial_rope(p[..., kv_lo:kv_lo + KV_WIDTH].reshape(B, S, N_KV_HEADS, HEAD_DIM), cos, sin)
        v = p[..., kv_lo + KV_WIDTH:kv_hi].reshape(B, S, N_KV_HEADS, HEAD_DIM)
        u = p[..., kv_hi:]
        kvc = hc @ w_in[i][:, kv_lo:kv_hi]
        C = xc.shape[1]
        kc = kvc[..., :KV_WIDTH].reshape(B, C, N_KV_HEADS, HEAD_DIM)
        vc = kvc[..., KV_WIDTH:].reshape(B, C, N_KV_HEADS, HEAD_DIM)

        attn = windowed_gqa_with_context(q, k, v, kc, vc, sink[i])
        four = fourier_mix(u, w_fourier[i])
        mix = jnp.concatenate([attn, four], axis=-1) @ w_out[i]
        x_mid = x + g1 * rmsnorm(mix, norm_post_mix[i])

        hf = modulate(rmsnorm(x_mid, norm_pre_ffn[i]), sh2, sc2)
        x = x_mid + g2 * rmsnorm(swiglu(hf, w_gate[i], w_up[i], w_down[i]), norm_post_ffn[i])

        if update_ctx:
            qc = (hc @ w_in[i][:, :ATTN_WIDTH]).reshape(B, C, N_Q_HEADS, HEAD_DIM)
            uc = hc @ w_in[i][:, kv_hi:]
            attn_c = context_gqa(qc, kc, vc, sink[i])
            four_c = fourier_mix(uc, w_fourier[i])
            mix_c = jnp.concatenate([attn_c, four_c], axis=-1) @ w_out[i]
            xc_mid = xc + cg1 * rmsnorm(mix_c, norm_post_mix[i])
            hfc = modulate(rmsnorm(xc_mid, norm_pre_ffn[i]), csh2, csc2)
            xc = xc_mid + cg2 * rmsnorm(swiglu(hfc, w_gate[i], w_up[i], w_down[i]), norm_post_ffn[i])
    return x
```

```cpp
#include <hip/hip_runtime.h>
#include <cstdint>
#include <cstdio>
#define MK_N_LAUNCHES 1
namespace mk {
#define LAS __attribute__((address_space(3)))
#define GAS __attribute__((address_space(1)))
typedef unsigned short bf16_t;
typedef short bf16x8 __attribute__((ext_vector_type(8)));
typedef float f32x4 __attribute__((ext_vector_type(4)));
typedef float f32x2 __attribute__((ext_vector_type(2)));
typedef float f32x16 __attribute__((ext_vector_type(16)));
typedef unsigned u32x4 __attribute__((ext_vector_type(4)));
typedef unsigned u32x2 __attribute__((ext_vector_type(2)));

constexpr int D = 1024, NB = 4, S = 4096, CL = 256, MLAT = NB * S, MCTX = NB * CL, MT = MLAT + MCTX;
constexpr int NQKV = 768, FF = 2816, NGU = 2 * FF, INW = 1280;
constexpr float C2 = 0.125f * 1.4426950408889634f;
constexpr float RMS_EPS = 1e-6f;
constexpr int NWAVES = 8;
constexpr int BM = 256, BK = 64, HALF = 128, HTB = HALF * BK * 2, STAGE_BYTES = 8 * HTB;

__device__ __forceinline__ int lds_byte(int r, int c) { const int st = (r >> 4) * 2 + (c >> 5), rr = r & 15, cc = c & 31, ob = rr * 64 + cc * 2; return st * 1024 + (ob ^ (((ob >> 9) & 1) << 5)); }
__device__ __forceinline__ void stage_rc(int b, int& R, int& C) { const int st = b / 1024, sb = b % 1024, swz = sb ^ (((sb >> 9) & 1) << 5); R = (st >> 1) * 16 + swz / 64; C = (st & 1) * 32 + (swz % 64) / 2; }
__device__ __forceinline__ int perm32(int rho) { const int n = rho >> 4, i = rho & 15; return 8 * (i >> 2) + 4 * n + (i & 3); }
typedef __bf16 bf16x2_t __attribute__((ext_vector_type(2)));
__device__ __forceinline__ unsigned cvt_pk_bf16(float lo, float hi) { unsigned r; asm volatile("v_cvt_pk_bf16_f32 %0, %1, %2" : "=v"(r) : "v"(lo), "v"(hi)); return r; }
__device__ __forceinline__ unsigned cvtpk_s(float lo, float hi) { const float __attribute__((ext_vector_type(2))) v = {lo, hi}; const bf16x2_t b = __builtin_convertvector(v, bf16x2_t); return __builtin_bit_cast(unsigned, b); }
__device__ __forceinline__ unsigned f2bf(float f) { unsigned u = __builtin_bit_cast(unsigned, f); return (u + 0x7fffu + ((u >> 16) & 1u)) >> 16; }
__device__ __forceinline__ unsigned pk2(float lo, float hi) { return f2bf(lo) | (f2bf(hi) << 16); }
__device__ __forceinline__ float bf2f(bf16_t v) { return __builtin_bit_cast(float, (unsigned)v << 16); }
__device__ __forceinline__ float wave_sum(float v) {
#pragma unroll
    for (int o = 1; o < 64; o <<= 1) v += __shfl_xor(v, o);
    return v;
}

struct Unit { const char* a; const char* b; int i0, i1, i2, i3; };

template <class Epi, class Sched, int BMAP, bool ALIGN_EPI>
__device__ __forceinline__ void gemm_phase(LAS unsigned char* lds, const int K, const Sched& S, const Epi& E) {
    const int tid = threadIdx.x, wid = __builtin_amdgcn_readfirstlane(tid >> 6), lane = tid & 63, wr = wid >> 2, wc = wid & 3, fr = lane & 15, fq = lane >> 4;
    const int nt = K / BK;
    unsigned voffA[2], voffB[2];
#pragma unroll
    for (int i = 0; i < 2; ++i) { int R, C; stage_rc(tid * 16 + i * 8192, R, C); const int Rb = Epi::PERM ? ((R & ~31) + perm32(R & 31)) : R;
        const int Rm = (BMAP == 1) ? (64 * (Rb & 63) + (Rb >> 6)) : Rb;
        voffA[i] = (unsigned)(R * K + C) * 2u; voffB[i] = (unsigned)(Rm * K + C) * 2u; }
    const size_t kstep = (size_t)(BK * 2);
    const size_t hstepA = (size_t)HALF * K * 2;
    const size_t hstepB = (BMAP == 1) ? (size_t)2 * K * 2 : (size_t)HALF * K * 2;
    const unsigned ldsw = (unsigned)wid * 1024u;
    const int aoff = lds_byte(wr * 64 + fr, fq * 8), boff = lds_byte(wc * 32 + fr, fq * 8);
#define PG8_SA(b, h) (((b) * 2 + (h)) * HTB)
#define PG8_SB(b, h) ((4 + (b) * 2 + (h)) * HTB)
#define PG8_STAGE(bufoff, gbase, voff) do { _Pragma("unroll") for (int _i = 0; _i < 2; ++_i) \
        __builtin_amdgcn_global_load_lds((const unsigned*)((const char*)(gbase) + (voff)[_i]), (LAS unsigned*)(lds + (bufoff) + ldsw + _i * 8192), 16, 0, 0); } while (0)
#define PG8_LDA(dst, b, h) do { _Pragma("unroll") for (int m = 0; m < 4; ++m) _Pragma("unroll") for (int k = 0; k < 2; ++k) dst[m][k] = *(const LAS bf16x8*)(lds + PG8_SA(b, h) + aoff + m * 2048 + k * 1024); } while (0)
#define PG8_LDB(dst, b, h) do { _Pragma("unroll") for (int n = 0; n < 2; ++n) _Pragma("unroll") for (int k = 0; k < 2; ++k) dst[n][k] = *(const LAS bf16x8*)(lds + PG8_SB(b, h) + boff + n * 2048 + k * 1024); } while (0)
#define PG8_MMA(ai, bj, At, Bt) do { __builtin_amdgcn_s_setprio(1); _Pragma("unroll") for (int m = 0; m < 4; ++m) _Pragma("unroll") for (int n = 0; n < 2; ++n) _Pragma("unroll") for (int k = 0; k < 2; ++k) \
        acc[ai][bj][m][n] = __builtin_amdgcn_mfma_f32_16x16x32_bf16(Bt[n][k], At[m][k], acc[ai][bj][m][n], 0, 0, 0); __builtin_amdgcn_s_setprio(0); } while (0)
#define PG8_WAIT_V(n) asm volatile("s_waitcnt vmcnt(" #n ")" ::: "memory")
#define PG8_WAIT_L(n) asm volatile("s_waitcnt lgkmcnt(" #n ")" ::: "memory")
#define PG8_BAR __builtin_amdgcn_s_barrier()
#define PG8_SCHED __builtin_amdgcn_sched_barrier(0)
    Unit cur, nxt; int ui = 0;
    if (!S.next(0, cur)) return;
    f32x4 acc[2][2][4][2];
#pragma unroll
    for (int a = 0; a < 2; ++a)
#pragma unroll
        for (int b = 0; b < 2; ++b)
#pragma unroll
            for (int m = 0; m < 4; ++m)
#pragma unroll
                for (int n = 0; n < 2; ++n) acc[a][b][m][n] = (f32x4){0.f, 0.f, 0.f, 0.f};
    bf16x8 At[4][2], B0[2][2], B1[2][2];
    const char* cA = cur.a; const char* cB = cur.b;
    PG8_STAGE(PG8_SB(0, 0), cB, voffB); PG8_STAGE(PG8_SB(0, 1), cB + hstepB, voffB); PG8_STAGE(PG8_SA(0, 0), cA, voffA); PG8_STAGE(PG8_SA(0, 1), cA + hstepA, voffA);
    if (wr == 1) PG8_BAR;
    PG8_WAIT_V(2); PG8_BAR;
    PG8_STAGE(PG8_SB(1, 0), cB + kstep, voffB); PG8_STAGE(PG8_SA(1, 0), cA + kstep, voffA); PG8_STAGE(PG8_SB(1, 1), cB + hstepB + kstep, voffB);
    PG8_WAIT_V(6); PG8_BAR;
    for (;;) {
        const bool has_next = S.next(ui + 1, nxt);
        const char* nA = has_next ? nxt.a : cA; const char* nB = has_next ? nxt.b : cB;
        for (int t = 0; t < nt; t += 2) {
            const bool last = (t == nt - 2);
            const char* a1 = cA + (size_t)(t + 1) * kstep;
            const char* a2 = last ? nA : cA + (size_t)(t + 2) * kstep; const char* b2 = last ? nB : cB + (size_t)(t + 2) * kstep;
            const char* a3 = a2 + kstep; const char* b3 = b2 + kstep;
            PG8_LDB(B0, 0, 0); PG8_LDB(B1, 0, 1); PG8_SCHED; PG8_LDA(At, 0, 0); PG8_STAGE(PG8_SA(1, 1), a1 + hstepA, voffA);
            PG8_WAIT_V(8); PG8_WAIT_L(0); PG8_BAR; PG8_MMA(0, 0, At, B0); PG8_MMA(0, 1, At, B1); PG8_BAR; PG8_SCHED;
            PG8_LDA(At, 0, 1); PG8_STAGE(PG8_SB(0, 0), b2, voffB); PG8_STAGE(PG8_SB(0, 1), b2 + hstepB, voffB); PG8_STAGE(PG8_SA(0, 0), a2, voffA);
            PG8_WAIT_V(8); PG8_WAIT_L(0); PG8_BAR; PG8_MMA(1, 0, At, B0); PG8_MMA(1, 1, At, B1); PG8_BAR; PG8_SCHED;
            PG8_LDB(B0, 1, 0); PG8_LDB(B1, 1, 1); PG8_SCHED; PG8_LDA(At, 1, 0); PG8_STAGE(PG8_SA(0, 1), a2 + hstepA, voffA);
            PG8_WAIT_V(8); PG8_WAIT_L(0); PG8_BAR; PG8_MMA(0, 0, At, B0); PG8_MMA(0, 1, At, B1); PG8_BAR; PG8_SCHED;
            PG8_LDA(At, 1, 1); PG8_STAGE(PG8_SB(1, 0), b3, voffB); PG8_STAGE(PG8_SB(1, 1), b3 + hstepB, voffB); PG8_STAGE(PG8_SA(1, 0), a3, voffA);
            PG8_WAIT_V(8); PG8_WAIT_L(0); PG8_BAR; PG8_MMA(1, 0, At, B0); PG8_MMA(1, 1, At, B1); PG8_BAR; PG8_SCHED;
        }
        if constexpr (ALIGN_EPI) { if (wr == 0) PG8_BAR; }
        if constexpr (!Epi::AFTER_DRAIN) { E(acc, cur, wr, wc, fr, fq); }
        if (!has_next) break;
#pragma unroll
        for (int a = 0; a < 2; ++a)
#pragma unroll
            for (int b = 0; b < 2; ++b)
#pragma unroll
                for (int m = 0; m < 4; ++m)
#pragma unroll
                    for (int n = 0; n < 2; ++n) acc[a][b][m][n] = (f32x4){0.f, 0.f, 0.f, 0.f};
        cur = nxt; cA = nA; cB = nB; ++ui;
        if constexpr (ALIGN_EPI) { if (wr == 1) PG8_BAR; }
    }
    PG8_WAIT_V(0);
    if constexpr (!ALIGN_EPI) { if (wr == 0) PG8_BAR; }
    PG8_BAR;
    if constexpr (Epi::AFTER_DRAIN) { E.fused(acc, cur, wr, wc, fr, fq, lds, wid, lane); }
#undef PG8_SA
#undef PG8_SB
#undef PG8_STAGE
#undef PG8_LDA
#undef PG8_LDB
#undef PG8_MMA
#undef PG8_WAIT_V
#undef PG8_WAIT_L
#undef PG8_BAR
#undef PG8_SCHED
}
constexpr size_t MiB = 1u << 20;
#ifndef MK_WS_MAP_HYBRID
#define MK_WS_MAP_HYBRID 0
#endif
constexpr size_t WS_CTL = 0, CTL_ZERO_BYTES = 1 * MiB;
constexpr size_t CTL_MOD_OFF = 512 * 1024;
constexpr size_t W_QKV = 0, W_Z = 1536 * 1024, W_O = W_Z + 2 * MiB, W_GU = W_O + 2 * MiB, W_D = W_GU + 11 * MiB, W_LAYER = 22 * MiB;
#if MK_WS_MAP_HYBRID
constexpr size_t WS_TAB = 6 * MiB;
constexpr size_t WS_ZT = 8 * MiB, WS_ZTC = 40 * MiB;
constexpr size_t WS_XN = 161 * MiB;
constexpr size_t WS_Q = 195 * MiB, WS_K = 212 * MiB, WS_V = WS_K + 4352 * 1024;
constexpr size_t WS_W = 229 * MiB;
constexpr size_t W_LSTRIDE = 4 * MiB;
constexpr size_t WS_AO = 76 * MiB;
#else
constexpr size_t WS_TAB = 1 * MiB;
constexpr size_t WS_W = 2 * MiB; constexpr size_t W_LSTRIDE = W_LAYER;
constexpr size_t WS_XN = 46 * MiB;
constexpr size_t WS_Q = 80 * MiB, WS_K = 97 * MiB, WS_V = WS_K + 4352 * 1024, WS_ZT = WS_V + 4352 * 1024, WS_ZTC = WS_ZT + 32 * MiB, WS_AO = WS_ZTC + 2 * MiB;
constexpr size_t WS_HID = 80 * MiB;
constexpr size_t WS_Y = 174 * MiB;
constexpr size_t WS_XC = 242 * MiB;
#endif
constexpr size_t TAB_ROPE = 0;

struct Args {
    const float* in[17]; float* out; unsigned char* ws;
    const float* xsrc; const float* xcsrc;
    int ph_lo, ph_hi, layer, pad;
};

struct Frame {
    LAS unsigned char* lds;
    int tid, lane, wave, vcu, G;
};

__device__ __forceinline__ void p0_tr_item(const float* W, int pitch, int k0, int n0src, bf16_t* WT, int K, int drow0, LAS float* scr, int lane) {
#pragma unroll 8
    for (int i = 0; i < 32; ++i) { const int kk = 2 * i + (lane >> 5); scr[kk * 33 + (lane & 31)] = W[(size_t)(k0 + kk) * pitch + n0src + (lane & 31)]; }
    asm volatile("s_waitcnt lgkmcnt(0)" ::: "memory");
    const int c = lane & 7;
#pragma unroll
    for (int j = 0; j < 4; ++j) { const int n = (lane >> 3) + 8 * j; const LAS float* s = scr + (8 * c) * 33 + n;
        u32x4 o; o.x = pk2(s[0 * 33], s[1 * 33]); o.y = pk2(s[2 * 33], s[3 * 33]); o.z = pk2(s[4 * 33], s[5 * 33]); o.w = pk2(s[6 * 33], s[7 * 33]);
        *(u32x4*)(WT + (size_t)(drow0 + n) * K + k0 + 8 * c) = o; }
    asm volatile("s_waitcnt lgkmcnt(0)" ::: "memory");
}

__device__ __forceinline__ void p0_fold_item(const float* w_in_l, const float* wf_l, bf16_t* WZ, int type, int g, int k0, LAS float* scr, LAS float* tb, int lane) {
    LAS float* M = scr;
    { float s, c; sincospif((float)lane / 32.0f, &s, &c); tb[lane] = type == 0 ? c : s; }
    float wfr[64];
#pragma unroll
    for (int cp = 0; cp < 64; ++cp) wfr[cp] = wf_l[(size_t)g * 4096 + cp * 64 + lane];
    asm volatile("s_waitcnt lgkmcnt(0)" ::: "memory");
    for (int c = 0; c < 64; ++c) { float a = 0.f;
#pragma unroll
        for (int cp = 0; cp < 64; ++cp) a += tb[(c * cp) & 63] * wfr[cp];
        M[c * 64 + lane] = a * (1.0f / 512.0f); }
    asm volatile("s_waitcnt lgkmcnt(0)" ::: "memory");
    float mr[64];
#pragma unroll
    for (int c = 0; c < 64; ++c) mr[c] = M[c * 64 + lane];
    bf16_t* orow = WZ + (size_t)(type * 512 + g * 64 + lane) * D + k0;
    for (int k = 0; k < 64; k += 2) {
        const float* w0 = w_in_l + (size_t)(k0 + k) * INW + 768 + g * 64; const float* w1 = w0 + INW;
        float a0 = 0.f, a1 = 0.f;
#pragma unroll
        for (int c = 0; c < 64; ++c) { a0 += w0[c] * mr[c]; a1 += w1[c] * mr[c]; }
        *(unsigned*)(orow + k) = pk2(a0, a1);
    }
    asm volatile("s_waitcnt lgkmcnt(0)" ::: "memory");
}

__device__ __forceinline__ void p0_adaln_item(const float* c, const float* c_ctx, const float* w_ada, const float* b_ada, float* mod, int l, int cb, int ks, int lane) {
    const int col0 = cb * 256 + lane * 4;
    f32x4 acc[5];
#pragma unroll
    for (int r = 0; r < 5; ++r) acc[r] = (f32x4){0.f, 0.f, 0.f, 0.f};
    const float* wp = w_ada + ((size_t)l * 1024 + ks * 32) * 6144 + col0;
#pragma unroll 8
    for (int kk = 0; kk < 32; ++kk) { const int k = ks * 32 + kk; const f32x4 w = *(const f32x4*)(wp + (size_t)kk * 6144);
#pragma unroll
        for (int r = 0; r < 5; ++r) { const float v = r < 4 ? c[r * 1024 + k] : c_ctx[k]; const float s = v / (1.0f + __expf(-v)); acc[r] += s * w; } }
    if (ks == 0) { const f32x4 b = *(const f32x4*)(b_ada + l * 6144 + col0);
#pragma unroll
        for (int r = 0; r < 5; ++r) acc[r] += b; }
#pragma unroll
    for (int r = 0; r < 5; ++r)
#pragma unroll
        for (int j = 0; j < 4; ++j) atomicAdd(mod + (size_t)(l * 5 + r) * 6144 + col0 + j, acc[r][j]);
}

__device__ __forceinline__ void normmod_row(const float* xrow, const float* gain, const float* sh, const float* sc, bf16_t* orow, int lane) {
    f32x4 v[4]; float ss = 0.f;
#pragma unroll
    for (int j = 0; j < 4; ++j) { v[j] = *(const f32x4*)(xrow + lane * 4 + 256 * j); ss += (v[j][0] * v[j][0] + v[j][1] * v[j][1]) + (v[j][2] * v[j][2] + v[j][3] * v[j][3]); }
    const float rs = rsqrtf(wave_sum(ss) * (1.0f / D) + RMS_EPS);
#pragma unroll
    for (int j = 0; j < 4; ++j) { const int idx = lane * 4 + 256 * j; const f32x4 g = *(const f32x4*)(gain + idx), a = *(const f32x4*)(sc + idx), b = *(const f32x4*)(sh + idx);
        const f32x4 o = v[j] * rs * g * (1.0f + a) + b;
        u32x2 w; w.x = pk2(o[0], o[1]); w.y = pk2(o[2], o[3]); *(u32x2*)(orow + idx) = w; }
}

struct SchedZ { const char* WZ; const char* XN; int vcu;
    __device__ __forceinline__ bool next(int i, Unit& u) const { if (i > 0) return false; const int x = vcu >> 5, q = vcu & 31; const int tt = 8 * x + (q >> 2), zp = q & 3;
        u.a = WZ + (size_t)zp * 256 * D * 2; u.b = XN + ((size_t)(tt >> 4) * S + 4 * (tt & 15)) * D * 2; u.i0 = tt; u.i1 = zp; u.i2 = 0; u.i3 = 0; return true; } };
struct SchedQKV { const char* XN; const char* W; int vcu; int full_ctx;
    __device__ __forceinline__ bool next(int i, Unit& u) const { if (i > 0) return false; const int x = vcu >> 5, q = vcu & 31; int tile, pn;
        if (q < 24) { tile = 8 * x + q / 3; pn = q % 3; }
        else { const int e = x * 8 + (q - 24); if (full_ctx) { if (e >= 12) return false; tile = 64 + e / 3; pn = e % 3; } else { if (e >= 4) return false; tile = 64 + e; pn = 2; } }
        u.a = XN + (size_t)tile * 256 * D * 2; u.b = W + (size_t)pn * 256 * D * 2; u.i0 = tile; u.i1 = pn; u.i2 = 0; u.i3 = 0; return true; } };
struct SchedZc { const char* WZ; const char* XN; int vcu;
    __device__ __forceinline__ bool next(int i, Unit& u) const { if (i > 0) return false; const int x = vcu >> 5, q = vcu & 31; if (q < 24) return false; const int e = x * 8 + (q - 24) - 12; if (e < 0 || e >= 16) return false;
        const int cb = e >> 2, zp = e & 3; u.a = WZ + (size_t)zp * 256 * D * 2; u.b = XN + ((size_t)MLAT + cb * 256) * D * 2; u.i0 = cb; u.i1 = zp; u.i2 = 0; u.i3 = 0; return true; } };

struct EpiQKV {
    static constexpr bool PERM = true, AFTER_DRAIN = false;
    bf16_t* Q; bf16_t* Kb; bf16_t* Vb; const float* rope;
    __device__ __forceinline__ void operator()(const f32x4 (&acc)[2][2][4][2], const Unit& u, int wr, int wc, int fr, int fq) const {
        const int tile = u.i0, pn = u.i1; const bool lat = tile < 64;
#pragma unroll
        for (int ai = 0; ai < 2; ++ai)
#pragma unroll
            for (int m = 0; m < 4; ++m) { const int row = tile * 256 + ai * HALF + wr * 64 + m * 16 + fr; const int t = row & (S - 1), gr = t >> 6, gc = t & 63;
#pragma unroll
                for (int bj = 0; bj < 2; ++bj) { const int colt = bj * HALF + wc * 32 + 8 * fq; f32x4 v0 = acc[ai][bj][m][0], v1 = acc[ai][bj][m][1];
                    const bool isV = (pn == 2) && (bj == 1);
                    if (lat && !isV) { const int i0 = (colt & 63) >> 1; const int pos = i0 < 16 ? gr : gc; const f32x4* tp = (const f32x4*)(rope + (size_t)(pos * 16 + (i0 & 15)) * 2);
                        const f32x4 c01 = tp[0], c23 = tp[1];
                        v0 = (f32x4){v0[0] * c01[0] - v0[1] * c01[1], v0[0] * c01[1] + v0[1] * c01[0], v0[2] * c01[2] - v0[3] * c01[3], v0[2] * c01[3] + v0[3] * c01[2]};
                        v1 = (f32x4){v1[0] * c23[0] - v1[1] * c23[1], v1[0] * c23[1] + v1[1] * c23[0], v1[2] * c23[2] - v1[3] * c23[3], v1[2] * c23[3] + v1[3] * c23[2]}; }
                    bf16_t* dst;
                    if (pn < 2) { v0 = v0 * C2; v1 = v1 * C2; dst = Q + (size_t)row * 512 + pn * 256 + colt; }
                    else if (bj == 0) dst = Kb + (size_t)row * 128 + colt;
                    else dst = Vb + (size_t)row * 128 + (colt - 128);
                    u32x4 w; w.x = cvt_pk_bf16(v0[0], v0[1]); w.y = cvt_pk_bf16(v0[2], v0[3]); w.z = cvt_pk_bf16(v1[0], v1[1]); w.w = cvt_pk_bf16(v1[2], v1[3]);
                    *(u32x4*)dst = w; } }
    }
};
struct EpiZ {
    static constexpr bool PERM = true, AFTER_DRAIN = false;
    bf16_t* ZT;
    __device__ __forceinline__ void operator()(const f32x4 (&acc)[2][2][4][2], const Unit& u, int wr, int wc, int fr, int fq) const {
        const int tt = u.i0, zp = u.i1, b = tt >> 4, n2_0 = (tt & 15) * 4, type = zp >> 1;
#pragma unroll
        for (int ai = 0; ai < 2; ++ai)
#pragma unroll
            for (int m = 0; m < 4; ++m) { const int ch = (zp & 1) * 256 + ai * HALF + wr * 64 + m * 16 + fr; bf16_t* base = ZT + (((size_t)ch * 4 + b) * 2 + type) * 4096;
#pragma unroll
                for (int bj = 0; bj < 2; ++bj) { const int j = bj * HALF + wc * 32 + 8 * fq; const int n2 = n2_0 + (j >> 6), n1 = j & 63; const f32x4 v0 = acc[ai][bj][m][0], v1 = acc[ai][bj][m][1];
                    u32x4 w; w.x = cvt_pk_bf16(v0[0], v0[1]); w.y = cvt_pk_bf16(v0[2], v0[3]); w.z = cvt_pk_bf16(v1[0], v1[1]); w.w = cvt_pk_bf16(v1[2], v1[3]);
                    *(u32x4*)(base + n2 * 64 + n1) = w; } }
    }
};
struct EpiZc {
    static constexpr bool PERM = true, AFTER_DRAIN = false;
    bf16_t* ZTc;
    __device__ __forceinline__ void operator()(const f32x4 (&acc)[2][2][4][2], const Unit& u, int wr, int wc, int fr, int fq) const {
        const int b = u.i0, zp = u.i1, type = zp >> 1;
#pragma unroll
        for (int ai = 0; ai < 2; ++ai)
#pragma unroll
            for (int m = 0; m < 4; ++m) { const int ch = (zp & 1) * 256 + ai * HALF + wr * 64 + m * 16 + fr; bf16_t* base = ZTc + (((size_t)b * 512 + ch) * 2 + type) * 256;
#pragma unroll
                for (int bj = 0; bj < 2; ++bj) { const int j = bj * HALF + wc * 32 + 8 * fq; const f32x4 v0 = acc[ai][bj][m][0], v1 = acc[ai][bj][m][1];
                    u32x4 w; w.x = cvt_pk_bf16(v0[0], v0[1]); w.y = cvt_pk_bf16(v0[2], v0[3]); w.z = cvt_pk_bf16(v1[0], v1[1]); w.w = cvt_pk_bf16(v1[2], v1[3]);
                    *(u32x4*)(base + j) = w; } }
    }
};
namespace att {
constexpr int KT_BYTES = 8192, BUF_BYTES = 2 * KT_BYTES, LDS_WS = 2 * BUF_BYTES;
constexpr int LDS_BYTES_ATT = LDS_WS + 8 * 256;
__device__ __forceinline__ int crow(int r, int hi) { return (r & 3) + 8 * (r >> 2) + 4 * hi; }
typedef short s16x4 __attribute__((ext_vector_type(4)));
__device__ __forceinline__ s16x4 vtr(const LAS unsigned char* p) { return __builtin_bit_cast(s16x4, __builtin_amdgcn_ds_read_tr16_b64_v4i16((LAS s16x4*)p)); }
__device__ __forceinline__ void hswap(unsigned& a, unsigned& b) { asm volatile("s_nop 1\n\tv_permlane32_swap_b32 %0, %1" : "+v"(a), "+v"(b)); }
__device__ __forceinline__ float hswap_max(float v) { unsigned a = __builtin_bit_cast(unsigned, v), b = a; hswap(a, b); return fmaxf(__builtin_bit_cast(float, a), __builtin_bit_cast(float, b)); }
__device__ __forceinline__ float hswap_sum(float v) { unsigned a = __builtin_bit_cast(unsigned, v), b = a; hswap(a, b); return __builtin_bit_cast(float, a) + __builtin_bit_cast(float, b); }

__device__ __forceinline__ void attn_unit(LAS unsigned char* lds, const bf16_t* Q, const bf16_t* Kb, const bf16_t* Vb, bf16_t* AO, const float* sinkl,
                                          int qrow0, int kvh, int krow_ctx, int krow_lat, int qb) {
    const int tid = threadIdx.x, lane = tid & 63, r32 = lane & 31, hi = lane >> 5; const int wid = __builtin_amdgcn_readfirstlane(tid >> 6);
    const int g = wid >> 1, half = wid & 1, h = kvh * 4 + g;
    LAS float* wsf = (LAS float*)(lds + LDS_WS) + wid * 64;
    int jlo = 0, jhi = -1;
    if (krow_lat >= 0) { jlo = qb - 2 < 0 ? 0 : qb - 2; jhi = qb + 2 > 63 ? 63 : qb + 2; }
    const int NT = 4 + (jhi - jlo + 1);
    const bf16_t* Qw = Q + (size_t)(qrow0 + 32 * half + r32) * 512 + h * 64;
    bf16x8 qr[4];
#pragma unroll
    for (int d0 = 0; d0 < 4; ++d0) qr[d0] = *(const bf16x8*)(Qw + d0 * 16 + hi * 8);
    const int krow_of_lane = lane, vrow_of_lane = 16 * (wid & 3) + (lane >> 2);
    const size_t koff = (size_t)krow_of_lane * 128 + kvh * 64 + wid * 8;
    const size_t voff = (size_t)vrow_of_lane * 128 + kvh * 64 + (wid >> 2) * 32 + (lane & 3) * 8;
    const int sdst = wid * 1024 + lane * 16;
    auto tile_row = [&](int t) -> int { return t < 4 ? krow_ctx + 64 * t : krow_lat + 64 * (jlo + t - 4); };
    u32x4 kreg, vreg;
    { const int kr = tile_row(0); kreg = *(const u32x4*)(Kb + (size_t)kr * 128 + koff); vreg = *(const u32x4*)(Vb + (size_t)kr * 128 + voff); }
    *(LAS u32x4*)(lds + sdst) = kreg; *(LAS u32x4*)(lds + KT_BYTES + sdst) = vreg;
    __syncthreads();
    float m_run = -1e30f, l_run = 0.f;
    f32x16 o0 = {}, o1 = {};
    const int qtok = 64 * qb + 32 * half + r32;
    for (int t = 0; t < NT; ++t) {
        const LAS unsigned char* kb_ = lds + (t & 1) * BUF_BYTES; const LAS unsigned char* vb_ = kb_ + KT_BYTES;
        if (t + 1 < NT) { const int kr = tile_row(t + 1); kreg = *(const u32x4*)(Kb + (size_t)kr * 128 + koff); vreg = *(const u32x4*)(Vb + (size_t)kr * 128 + voff); }
        f32x16 p0 = {}, p1 = {};
        { const LAS unsigned char* kp = kb_ + hi * 1024 + r32 * 16;
#pragma unroll
          for (int d0 = 0; d0 < 4; ++d0) { const bf16x8 a0 = *(const LAS bf16x8*)(kp + d0 * 2048), a1 = *(const LAS bf16x8*)(kp + d0 * 2048 + 512);
              p0 = __builtin_amdgcn_mfma_f32_32x32x16_bf16(a0, qr[d0], p0, 0, 0, 0); p1 = __builtin_amdgcn_mfma_f32_32x32x16_bf16(a1, qr[d0], p1, 0, 0, 0); } }
        if (t >= 4) { const int jt = jlo + t - 4; const int dq = jt - qb;
            if (dq == 2 || dq == -2) { const int kbase = 64 * jt + 4 * hi - qtok;
#pragma unroll
                for (int r = 0; r < 16; ++r) { const int dj = kbase + (r & 3) + 8 * (r >> 2);
                    if (dj < -128 || dj > 128) p0[r] = -1e30f; if (dj + 32 < -128 || dj + 32 > 128) p1[r] = -1e30f; } } }
        float mx = fmaxf(p0[0], p1[0]);
#pragma unroll
        for (int r = 1; r < 16; ++r) mx = fmaxf(mx, fmaxf(p0[r], p1[r]));
        mx = hswap_max(mx);
        const float mnew = fmaxf(m_run, mx); const float alpha = __builtin_amdgcn_exp2f(m_run - mnew); m_run = mnew;
        float ps = 0.f;
#pragma unroll
        for (int r = 0; r < 16; ++r) { p0[r] = __builtin_amdgcn_exp2f(p0[r] - mnew); p1[r] = __builtin_amdgcn_exp2f(p1[r] - mnew); ps += p0[r] + p1[r]; }
        l_run = l_run * alpha + ps;
        if (hi == 0) wsf[r32] = alpha;
        asm volatile("s_waitcnt lgkmcnt(0)" ::: "memory");
#pragma unroll
        for (int r = 0; r < 16; ++r) { const float f = wsf[crow(r, hi)]; o0[r] *= f; o1[r] *= f; }
        u32x4 pa[4];
#pragma unroll
        for (int s = 0; s < 2; ++s) {
            pa[s]     = (u32x4){cvtpk_s(p0[8 * s], p0[8 * s + 1]), cvtpk_s(p0[8 * s + 2], p0[8 * s + 3]), cvtpk_s(p0[8 * s + 4], p0[8 * s + 5]), cvtpk_s(p0[8 * s + 6], p0[8 * s + 7])};
            pa[2 + s] = (u32x4){cvtpk_s(p1[8 * s], p1[8 * s + 1]), cvtpk_s(p1[8 * s + 2], p1[8 * s + 3]), cvtpk_s(p1[8 * s + 4], p1[8 * s + 5]), cvtpk_s(p1[8 * s + 6], p1[8 * s + 7])}; }
        { const LAS unsigned char* vp = vb_ + ((lane >> 4) & 1) * 32 + (lane & 3) * 8 + (4 * hi + ((lane & 15) >> 2)) * 64;
#pragma unroll
          for (int ks = 0; ks < 4; ++ks) {
              const s16x4 l0 = vtr(vp + ks * 1024), h0 = vtr(vp + ks * 1024 + 512), l1 = vtr(vp + 4096 + ks * 1024), h1 = vtr(vp + 4096 + ks * 1024 + 512);
              const bf16x8 v0 = (bf16x8){l0[0], l0[1], l0[2], l0[3], h0[0], h0[1], h0[2], h0[3]}, v1 = (bf16x8){l1[0], l1[1], l1[2], l1[3], h1[0], h1[1], h1[2], h1[3]};
              const bf16x8 pf = __builtin_bit_cast(bf16x8, pa[ks]);
              o0 = __builtin_amdgcn_mfma_f32_32x32x16_bf16(pf, v0, o0, 0, 0, 0); o1 = __builtin_amdgcn_mfma_f32_32x32x16_bf16(pf, v1, o1, 0, 0, 0); } }
        if (t + 1 < NT) { LAS unsigned char* nb = lds + ((t + 1) & 1) * BUF_BYTES; *(LAS u32x4*)(nb + sdst) = kreg; *(LAS u32x4*)(nb + KT_BYTES + sdst) = vreg; }
        __syncthreads();
    }
    float l_tot = hswap_sum(l_run) + __builtin_amdgcn_exp2f(sinkl[h] * 1.4426950408889634f - m_run);
    if (hi == 0) wsf[32 + r32] = 1.0f / l_tot;
    asm volatile("s_waitcnt lgkmcnt(0)" ::: "memory");
    bf16_t* Ow = AO + (size_t)(qrow0 + 32 * half) * D + h * 64 + r32;
#pragma unroll
    for (int r = 0; r < 16; ++r) { const int q = crow(r, hi); const float f = wsf[32 + q];
        Ow[(size_t)q * D] = (bf16_t)f2bf(o0[r] * f); Ow[(size_t)q * D + 32] = (bf16_t)f2bf(o1[r] * f); }
    __syncthreads();
}
}
namespace fft {
constexpr int ROWB = 272;
constexpr int T_M1R = 0, T_M1I = 64 * ROWB, T_M2P = 2 * 64 * ROWB, T_TW = 3 * 64 * ROWB, T_BYTES = T_TW + 1024;
constexpr int L_TAB = 0, L_STG = 53248, LDS_BYTES_FFT = L_STG + 65536;
__device__ __forceinline__ int crow(int r, int hi) { return (r & 3) + 8 * (r >> 2) + 4 * hi; }

__device__ __forceinline__ void gen_table_entry(unsigned char* tab, int e) {
    if (e < 3 * 8192) { const int mat = e >> 13, row = (e >> 7) & 63, col = e & 127; float v;
        if (mat < 2) { const int type = col >> 6, n1 = col & 63; float s, c; sincospif((float)((n1 * row) & 63) / 32.0f, &s, &c);
            v = mat == 0 ? (type == 0 ? c : -s) : (type == 0 ? -s : -c); }
        else {
            const int f = col >> 4, hh = (col >> 3) & 1, j = col & 7, ri = f >> 2, rb = (f >> 1) & 1, s_ = f & 1; const int n2 = 32 * rb + 16 * s_ + 8 * (j >> 2) + 4 * hh + (j & 3);
            float s, c; sincospif((float)((n2 * row) & 63) / 32.0f, &s, &c); v = ri == 0 ? c : s; }
        *(bf16_t*)(tab + mat * 64 * ROWB + row * ROWB + col * 2) = (bf16_t)f2bf(v); }
    else { const int t = e - 3 * 8192; if (t < 128) { float s, c; if (t < 64) sincospif((float)t / 32.0f, &s, &c); else sincospif((float)(t - 64) / 2048.0f, &s, &c);
        float* p = (float*)(tab + T_TW) + 2 * t; p[0] = c; p[1] = s; } }
}

__device__ __forceinline__ void fft_load_tables(LAS unsigned char* lds, const unsigned char* tab) {
    for (int i = threadIdx.x; i < T_BYTES / 16; i += NWAVES * 64) *(LAS u32x4*)(lds + L_TAB + i * 16) = *(const u32x4*)(tab + i * 16);
}

__device__ __forceinline__ void fft_unit(LAS unsigned char* lds, const bf16_t* ZT, bf16_t* AO, int b, int chg) {
    const int tid = threadIdx.x, lane = tid & 63, r32 = lane & 31, hi = lane >> 5; const int wid = __builtin_amdgcn_readfirstlane(tid >> 6);
    const int ch = chg * 8 + wid;
    const bf16_t* zb = ZT + ((size_t)ch * 4 + b) * 2 * 4096;
    const LAS unsigned char* tM1r = lds + L_TAB + T_M1R; const LAS unsigned char* tM1i = lds + L_TAB + T_M1I; const LAS unsigned char* tM2 = lds + L_TAB + T_M2P;
    const LAS f32x2* TH = (const LAS f32x2*)(lds + L_TAB + T_TW); const LAS f32x2* TL = TH + 64;
    f32x16 out[2][2];
#pragma unroll
    for (int a = 0; a < 2; ++a)
#pragma unroll
        for (int c = 0; c < 2; ++c) out[a][c] = (f32x16){};
#pragma unroll
    for (int rb = 0; rb < 2; ++rb) {
        f32x16 Tr[2], Ti[2];
        Tr[0] = (f32x16){}; Tr[1] = (f32x16){}; Ti[0] = (f32x16){}; Ti[1] = (f32x16){};
        bf16x8 xa[8];
#pragma unroll
        for (int ks = 0; ks < 8; ++ks) xa[ks] = *(const bf16x8*)(zb + (size_t)(ks >> 2) * 4096 + (32 * rb + r32) * 64 + 16 * (ks & 3) + 8 * hi);
#pragma unroll
        for (int ks = 0; ks < 8; ++ks) {
#pragma unroll
            for (int cb = 0; cb < 2; ++cb) { const int boff = (32 * cb + r32) * ROWB + (16 * ks + 8 * hi) * 2;
                const bf16x8 br = *(const LAS bf16x8*)(tM1r + boff), bi = *(const LAS bf16x8*)(tM1i + boff);
                Tr[cb] = __builtin_amdgcn_mfma_f32_32x32x16_bf16(xa[ks], br, Tr[cb], 0, 0, 0); Ti[cb] = __builtin_amdgcn_mfma_f32_32x32x16_bf16(xa[ks], bi, Ti[cb], 0, 0, 0); } }
        u32x4 fr_[2][2][2];
#pragma unroll
        for (int cb = 0; cb < 2; ++cb) { const int k1 = 32 * cb + r32; float tr[16], ti[16];
#pragma unroll
            for (int r = 0; r < 16; ++r) { const int n2 = 32 * rb + crow(r, hi); const int m = n2 * k1; const f32x2 a = TH[m >> 6], bb = TL[m & 63];
                const float c = a[0] * bb[0] - a[1] * bb[1], s = a[1] * bb[0] + a[0] * bb[1];
                tr[r] = Tr[cb][r] * c + Ti[cb][r] * s; ti[r] = Ti[cb][r] * c - Tr[cb][r] * s; }
#pragma unroll
            for (int s_ = 0; s_ < 2; ++s_) {
                fr_[0][cb][s_] = (u32x4){cvt_pk_bf16(tr[8 * s_], tr[8 * s_ + 1]), cvt_pk_bf16(tr[8 * s_ + 2], tr[8 * s_ + 3]), cvt_pk_bf16(tr[8 * s_ + 4], tr[8 * s_ + 5]), cvt_pk_bf16(tr[8 * s_ + 6], tr[8 * s_ + 7])};
                fr_[1][cb][s_] = (u32x4){cvt_pk_bf16(ti[8 * s_], ti[8 * s_ + 1]), cvt_pk_bf16(ti[8 * s_ + 2], ti[8 * s_ + 3]), cvt_pk_bf16(ti[8 * s_ + 4], ti[8 * s_ + 5]), cvt_pk_bf16(ti[8 * s_ + 6], ti[8 * s_ + 7])}; } }
#pragma unroll
        for (int ri = 0; ri < 2; ++ri)
#pragma unroll
            for (int s_ = 0; s_ < 2; ++s_) { const int f = (ri * 2 + rb) * 2 + s_;
#pragma unroll
                for (int kb = 0; kb < 2; ++kb) { const bf16x8 am = *(const LAS bf16x8*)(tM2 + (32 * kb + r32) * ROWB + f * 32 + hi * 16);
#pragma unroll
                    for (int cb = 0; cb < 2; ++cb) out[kb][cb] = __builtin_amdgcn_mfma_f32_32x32x16_bf16(am, __builtin_bit_cast(bf16x8, fr_[ri][cb][s_]), out[kb][cb], 0, 0, 0); } }
    }
    LAS bf16_t* stg = (LAS bf16_t*)(lds + L_STG);
#pragma unroll
    for (int kb = 0; kb < 2; ++kb)
#pragma unroll
        for (int cb = 0; cb < 2; ++cb)
#pragma unroll
            for (int r = 0; r < 16; ++r) { const int k2 = 32 * kb + crow(r, hi), k1 = 32 * cb + r32; stg[(k1 + 64 * k2) * 8 + wid] = (bf16_t)f2bf(out[kb][cb][r]); }
    __syncthreads();
    bf16_t* ob = AO + (size_t)b * S * D + 512 + chg * 8;
    for (int n = tid; n < S; n += NWAVES * 64) *(u32x4*)(ob + (size_t)n * D) = *(const LAS u32x4*)(lds + L_STG + n * 16);
    __syncthreads();
}
}

struct EpiBf16 {
    static constexpr bool PERM = true, AFTER_DRAIN = false;
    bf16_t* O; int ldc;
    __device__ __forceinline__ void operator()(const f32x4 (&acc)[2][2][4][2], const Unit& u, int wr, int wc, int fr, int fq) const {
        bf16_t* base = O + (size_t)u.i2 + (size_t)(u.i0 * 256 + wr * 64 + fr) * ldc + u.i1 * 256 + wc * 32 + 8 * fq;
#pragma unroll
        for (int ai = 0; ai < 2; ++ai)
#pragma unroll
            for (int m = 0; m < 4; ++m)
#pragma unroll
                for (int bj = 0; bj < 2; ++bj) { const f32x4 v0 = acc[ai][bj][m][0], v1 = acc[ai][bj][m][1];
                    u32x4 w; w.x = cvt_pk_bf16(v0[0], v0[1]); w.y = cvt_pk_bf16(v0[2], v0[3]); w.z = cvt_pk_bf16(v1[0], v1[1]); w.w = cvt_pk_bf16(v1[2], v1[3]);
                    *(u32x4*)(base + (size_t)(ai * HALF + m * 16) * ldc + bj * HALF) = w; }
    }
};
struct SchedFc { const char* Dc; const char* ZTc; int vcu;
    __device__ __forceinline__ bool next(int i, Unit& u) const { if (i > 0 || (vcu & 7) != 4 || (vcu >> 3) >= 8) return false; const int e = vcu >> 3, b = e >> 1, pn = e & 1;
        u.a = Dc; u.b = ZTc + ((size_t)b * 512 + pn * 256) * 512 * 2; u.i0 = 0; u.i1 = pn; u.i2 = (MLAT + b * 256) * D + 512; u.i3 = 0; return true; } };
struct SchedMN { const char* A; const char* B; int K, nM, nN, G, c;
    __device__ __forceinline__ bool next(int i, Unit& u) const {
        const int nwg = nM * nN; const long L = (long)i * G + c; if (L >= nwg) return false;
        int wgid = (int)L; { const int q = nwg / 8, r = nwg % 8, xcd = wgid % 8, off = wgid / 8; wgid = (xcd < r ? xcd * (q + 1) : r * (q + 1) + (xcd - r) * q) + off; }
        const int nig = 8 * nN, gid = wgid / nig, fm = gid * 8, gsz = (nM - fm) < 8 ? (nM - fm) : 8;
        const int pm = fm + ((wgid % nig) % gsz), pn = (wgid % nig) / gsz;
        u.a = A + (size_t)pm * 256 * K * 2; u.b = B + (size_t)pn * 256 * K * 2; u.i0 = pm; u.i1 = pn; u.i2 = 0; u.i3 = 0; return true; } };

struct EpiF32 {
    static constexpr bool PERM = false, AFTER_DRAIN = false;
    float* C; int ldc;
    __device__ __forceinline__ void operator()(const f32x4 (&acc)[2][2][4][2], const Unit& u, int wr, int wc, int fr, int fq) const {
        const int row0 = u.i0 * BM + wr * 64 + fr, col0 = u.i1 * BM + wc * 32 + 4 * fq;
#pragma unroll
        for (int ai = 0; ai < 2; ++ai)
#pragma unroll
            for (int m = 0; m < 4; ++m) { float* rowp = C + (size_t)(row0 + ai * HALF + m * 16) * ldc + col0;
#pragma unroll
                for (int bj = 0; bj < 2; ++bj)
#pragma unroll
                    for (int n = 0; n < 2; ++n) *(f32x4*)(rowp + bj * HALF + n * 16) = acc[ai][bj][m][n]; }
    }
};
struct EpiSwiGLU {
    static constexpr bool PERM = true, AFTER_DRAIN = false;
    bf16_t* Hd;
    __device__ __forceinline__ void operator()(const f32x4 (&acc)[2][2][4][2], const Unit& u, int wr, int wc, int fr, int fq) const {
        bf16_t* base = Hd + (size_t)(u.i0 * BM + wr * 64 + fr) * FF + u.i1 * HALF + wc * 32 + 8 * fq;
#pragma unroll
        for (int ai = 0; ai < 2; ++ai)
#pragma unroll
            for (int m = 0; m < 4; ++m) { float o[8];
#pragma unroll
                for (int n = 0; n < 2; ++n)
#pragma unroll
                    for (int j = 0; j < 4; ++j) { const float g = acc[ai][0][m][n][j], up = acc[ai][1][m][n][j];
                        const float sg = __builtin_amdgcn_rcpf(1.0f + __builtin_amdgcn_exp2f(-1.4426950408889634f * g)); o[4 * n + j] = g * sg * up; }
                u32x4 w; w.x = pk2(o[0], o[1]); w.y = pk2(o[2], o[3]); w.z = pk2(o[4], o[5]); w.w = pk2(o[6], o[7]);
                *(u32x4*)(base + (size_t)(ai * HALF + m * 16) * FF) = w; }
    }
};

__device__ __forceinline__ void post_row(const float* yrow, const float* xirow, float* xorow, const float* gain, const float* gate,
                                         bool do_xn, const float* gain2, const float* sh, const float* sc, bf16_t* xnrow, int lane) {
    f32x4 y[4], x[4]; float ss = 0.f;
#pragma unroll
    for (int j = 0; j < 4; ++j) { y[j] = *(const f32x4*)(yrow + lane * 4 + 256 * j); x[j] = *(const f32x4*)(xirow + lane * 4 + 256 * j);
        ss += (y[j][0] * y[j][0] + y[j][1] * y[j][1]) + (y[j][2] * y[j][2] + y[j][3] * y[j][3]); }
    const float rs = rsqrtf(wave_sum(ss) * (1.0f / D) + RMS_EPS);
    float s2 = 0.f;
#pragma unroll
    for (int j = 0; j < 4; ++j) { const int idx = lane * 4 + 256 * j; const f32x4 g = *(const f32x4*)(gain + idx), a = *(const f32x4*)(gate + idx);
        x[j] = x[j] + a * (y[j] * rs * g); *(f32x4*)(xorow + idx) = x[j];
        s2 += (x[j][0] * x[j][0] + x[j][1] * x[j][1]) + (x[j][2] * x[j][2] + x[j][3] * x[j][3]); }
    if (do_xn) { const float r2 = rsqrtf(wave_sum(s2) * (1.0f / D) + RMS_EPS);
#pragma unroll
        for (int j = 0; j < 4; ++j) { const int idx = lane * 4 + 256 * j; const f32x4 g = *(const f32x4*)(gain2 + idx), a = *(const f32x4*)(sc + idx), b = *(const f32x4*)(sh + idx);
            const f32x4 o = x[j] * r2 * g * (1.0f + a) + b; u32x2 w; w.x = pk2(o[0], o[1]); w.y = pk2(o[2], o[3]); *(u32x2*)(xnrow + idx) = w; } }
}
#define XB_TMO      128
#define XB_XCNT(j)  (256  + 64 * (j))
#define XB_XSUB(j)  (1280 + 64 * (j))
#define XB_XGEN(j)  (2304 + 64 * (j))
#define XB_TOP      3328
#define XB_TOPGEN   3392
#define XCD_BAR_WORDS 3456
#define XB_SPIN_CAP (1u << 18)
__device__ __forceinline__ unsigned xb_ld(unsigned* p)              { return __hip_atomic_load(p, __ATOMIC_RELAXED, __HIP_MEMORY_SCOPE_AGENT); }
__device__ __forceinline__ unsigned xb_add(unsigned* p, unsigned v) { return __hip_atomic_fetch_add(p, v, __ATOMIC_RELAXED, __HIP_MEMORY_SCOPE_AGENT); }
__device__ __forceinline__ unsigned xb_xcc_id() { return (unsigned)__builtin_amdgcn_s_getreg((3 << 11) | 20) & 0xFu; }
#define XB_SPIN(cond, bar) do { unsigned _sp = 0; while (cond) { __builtin_amdgcn_s_sleep(1); \
    if ((++_sp & 255u) == 0u) { if (xb_ld(&(bar)[XB_TMO])) break; if (_sp > XB_SPIN_CAP) { atomicAdd(&(bar)[XB_TMO], 1u); break; } } } } while (0)
struct XcdBarrier { unsigned* bar; unsigned x; volatile LAS unsigned* st; };
__device__ __forceinline__ XcdBarrier xcd_barrier_post(unsigned* bar, volatile LAS unsigned* st) {
    XcdBarrier b; b.bar = bar; b.x = xb_xcc_id(); b.st = st;
    if (threadIdx.x == 0) (void)xb_add(&bar[XB_XCNT(b.x)], 1u);
    return b;
}
__device__ __forceinline__ void xcd_barrier_complete(unsigned* bar, unsigned x, unsigned& nloc, unsigned& nx) {
    const unsigned G = gridDim.x * gridDim.y * gridDim.z;
    unsigned sum, cnt, mine, sp = 0u;
    for (;;) {
        sum = 0u; cnt = 0u; mine = 0u;
#pragma unroll
        for (unsigned j = 0; j < 16; ++j) { const unsigned c = xb_ld(&bar[XB_XCNT(j)]); sum += c; cnt += (c > 0u) ? 1u : 0u; mine = (j == x) ? c : mine; }
        if (sum == G) break;
        __builtin_amdgcn_s_sleep(1);
        if ((++sp & 255u) == 0u) { if (xb_ld(&bar[XB_TMO])) break; if (sp > XB_SPIN_CAP) { atomicAdd(&bar[XB_TMO], 1u); break; } }
    }
    nloc = mine > 0u ? mine : 1u; nx = cnt > 0u ? cnt : 1u;
}
__device__ __forceinline__ void xcd_barrier(const XcdBarrier& b) {
    asm volatile("s_waitcnt vmcnt(0)" ::: "memory");
    __syncthreads();
    if (threadIdx.x == 0) {
        unsigned* bar = b.bar;
        __builtin_amdgcn_s_waitcnt(0);
        unsigned nloc = b.st[0], nx = b.st[1];
        if (nloc == 0u) { xcd_barrier_complete(bar, b.x, nloc, nx); b.st[0] = nloc; b.st[1] = nx; }
        const unsigned old = xb_add(&bar[XB_XSUB(b.x)], 1u);
        const unsigned gen = old / nloc;
        if (old + 1u == (gen + 1u) * nloc) {
            __builtin_amdgcn_fence(__ATOMIC_RELEASE, "agent");
            asm volatile("s_waitcnt vmcnt(0)" ::: "memory");
            const unsigned og = xb_add(&bar[XB_TOP], 1u);
            const unsigned tg = og / nx;
            if (og + 1u == (tg + 1u) * nx) xb_add(&bar[XB_TOPGEN], 1u);
            else XB_SPIN(xb_ld(&bar[XB_TOPGEN]) == tg, bar);
            __builtin_amdgcn_fence(__ATOMIC_ACQUIRE, "agent");
            xb_add(&bar[XB_XGEN(b.x)], 1u);
            asm volatile("s_waitcnt vmcnt(0)" ::: "memory");
        } else {
            XB_SPIN(xb_ld(&bar[XB_XGEN(b.x)]) == gen, bar);
            __builtin_amdgcn_fence(__ATOMIC_ACQUIRE, "agent");
            asm volatile("s_waitcnt vmcnt(0)" ::: "memory");
        }
    }
    __syncthreads();
}

constexpr int RING_BYTES = 131072, PRO_TB_OFF = RING_BYTES, LDSCTL_OFF = PRO_TB_OFF + 8 * 256, MISC_OFF = LDSCTL_OFF + 320, LDS_BYTES = 147456;
constexpr size_t TAB_FFT = 16384, TAB_DC = 131072;
constexpr int CW_BAR = 4096;
constexpr int N_PHASES = 16;
enum { SUB_INPROJ = 0, SUB_MIX = 1, SUB_OUT = 2, SUB_POST1 = 3, SUB_GATEUP = 4, SUB_DOWN = 5, SUB_POST2 = 6 };

struct Ctx {
    Frame F; unsigned char* ws; const float* const* in; float* out;
    const float *x_in, *c_in, *ctx_in, *c_ctx, *w_ada, *b_ada, *npm, *npo, *npf, *npof, *w_in, *w_out, *w_four, *w_gate, *w_up, *w_down, *sink;
    float *mod, *rope, *Y, *XC; unsigned char* tabs;
    bf16_t *XN, *Qb, *Kb, *Vb, *ZT, *ZTc, *AO, *HID;
    int gw, NGW;
};
template <int ph> __device__ __forceinline__ void run_phase(const Ctx& c) {
    constexpr int l = ph < 2 ? 0 : (ph - 2) / 7; constexpr int sub = ph < 2 ? -1 : (ph - 2) % 7;
    const Frame& F = c.F; unsigned char* ws = c.ws; float* out = c.out;
    const float *x_in = c.x_in, *c_in = c.c_in, *ctx_in = c.ctx_in, *c_ctx = c.c_ctx, *w_ada = c.w_ada, *b_ada = c.b_ada, *npm = c.npm, *npo = c.npo, *npf = c.npf, *npof = c.npof;
    const float *w_in = c.w_in, *w_out = c.w_out, *w_four = c.w_four, *w_gate = c.w_gate, *w_up = c.w_up, *w_down = c.w_down;
    float *mod = c.mod, *rope = c.rope, *Y = c.Y, *XC = c.XC; unsigned char* tabs = c.tabs;
    bf16_t *XN = c.XN, *Qb = c.Qb, *Kb = c.Kb, *Vb = c.Vb, *ZT = c.ZT, *ZTc = c.ZTc, *AO = c.AO, *HID = c.HID;
    const int gw = c.gw, NGW = c.NGW;
        const char* wl = (const char*)(ws + WS_W + (size_t)l * W_LSTRIDE);
        const int nMt = l == 0 ? 68 : 64;

        if constexpr (ph == 0) {
            LAS float* scr = (LAS float*)(F.lds + F.wave * 16384); LAS float* tb = (LAS float*)(F.lds + PRO_TB_OFF + F.wave * 256);
            constexpr int I_TR = 5120, I_FOLD = 256, I_ADA = 768, I_FT = 386, I_DC = 256;
            constexpr int NITEMS = 2 * (I_TR + I_FOLD + I_ADA) + 16 + I_FT + I_DC;
            for (int it = gw; it < NITEMS; it += NGW) {
                int r = it;
                if (r < 2 * I_TR) { const int ll = r / I_TR; r -= ll * I_TR; unsigned char* wll = ws + WS_W + (size_t)ll * W_LSTRIDE;
                    if (r < 384) { const int kb = r / 24, nb = r % 24; p0_tr_item(w_in + (size_t)ll * D * INW, INW, 64 * kb, 32 * nb, (bf16_t*)(wll + W_QKV), D, 32 * nb, scr, F.lane); continue; } r -= 384;
                    if (r < 512) { const int kb = r / 32, nb = r % 32; p0_tr_item(w_out + (size_t)ll * D * D, D, 64 * kb, 32 * nb, (bf16_t*)(wll + W_O), D, 32 * nb, scr, F.lane); continue; } r -= 512;
                    if (r < 1408) { const int kb = r / 88, nb = r % 88, n0 = 32 * nb; p0_tr_item(w_gate + (size_t)ll * D * FF, FF, 64 * kb, n0, (bf16_t*)(wll + W_GU), D, 256 * (n0 >> 7) + (n0 & 127), scr, F.lane); continue; } r -= 1408;
                    if (r < 1408) { const int kb = r / 88, nb = r % 88, n0 = 32 * nb; p0_tr_item(w_up + (size_t)ll * D * FF, FF, 64 * kb, n0, (bf16_t*)(wll + W_GU), D, 256 * (n0 >> 7) + 128 + (n0 & 127), scr, F.lane); continue; } r -= 1408;
                    { const int kb = r / 32, nb = r % 32; p0_tr_item(w_down + (size_t)ll * FF * D, D, 64 * kb, 32 * nb, (bf16_t*)(wll + W_D), FF, 32 * nb, scr, F.lane); }
                    continue; }
                r -= 2 * I_TR;
                if (r < 2 * I_FOLD) { const int ll = r / I_FOLD; r -= ll * I_FOLD; const int type = r >> 7, g = (r >> 4) & 7, kb = r & 15;
                    p0_fold_item(w_in + (size_t)ll * D * INW, w_four + (size_t)ll * 8 * 4096, (bf16_t*)(ws + WS_W + (size_t)ll * W_LSTRIDE + W_Z), type, g, 64 * kb, scr, tb, F.lane); continue; }
                r -= 2 * I_FOLD;
                if (r < 2 * I_ADA) { const int ll = r / I_ADA; r -= ll * I_ADA; p0_adaln_item(c_in, c_ctx, w_ada, b_ada, mod, ll, r >> 5, r & 31, F.lane); continue; }
                r -= 2 * I_ADA;
                if (r >= 16) { r -= 16;
                    if (r < I_FT) { fft::gen_table_entry(tabs + TAB_FFT, r * 64 + F.lane); continue; }
                    r -= I_FT;
                    bf16_t* dc = (bf16_t*)(tabs + TAB_DC) + (size_t)r * 512;
                    for (int i = 0; i < 8; ++i) { const int col = F.lane + 64 * i, type = col >> 8, n = col & 255; float s_, c_; sincospif((float)((n * r) & 255) / 128.0f, &s_, &c_); dc[col] = (bf16_t)f2bf(type == 0 ? 4.0f * c_ : -4.0f * s_); }
                    continue; }
                { const int e = r * 64 + F.lane; const int pos = e >> 4, f = e & 15; const float fr_ = powf(10000.0f, -(float)f / 16.0f); const float a = (float)pos * fr_; rope[2 * e] = cosf(a); rope[2 * e + 1] = sinf(a); }
            }
        }
        else if constexpr (ph == 1) {
            for (int m = gw; m < MT; m += NGW) {
                const float* src = m < MLAT ? x_in + (size_t)m * D : ctx_in + (size_t)(m - MLAT) * D;
                const int r = m < MLAT ? (m >> 12) : 4; const float* ml = mod + (size_t)r * 6144;
                normmod_row(src, npm, ml, ml + 1024, XN + (size_t)m * D, F.lane);
            }
        }
        else if constexpr (sub == SUB_INPROJ) {
            { SchedZ Sz{wl + W_Z, (const char*)XN, F.vcu}; EpiZ Ez{ZT}; gemm_phase<EpiZ, SchedZ, 1, false>(F.lds, D, Sz, Ez); }
            { SchedQKV Sq{(const char*)XN, wl + W_QKV, F.vcu, l == 0 ? 1 : 0}; EpiQKV Eq{Qb, Kb, Vb, rope}; gemm_phase<EpiQKV, SchedQKV, 0, false>(F.lds, D, Sq, Eq); }
            if (l == 0) { SchedZc Sc{wl + W_Z, (const char*)XN, F.vcu}; EpiZc Ec{ZTc}; gemm_phase<EpiZc, SchedZc, 0, false>(F.lds, D, Sc, Ec); }
        }
        else if constexpr (sub == SUB_MIX) {
            const float* sinkl = c.sink + l * 8;
            for (int i = 0; i < 2; ++i) { const int uid = F.vcu * 2 + i; const int b = uid >> 7, kvh = (uid >> 6) & 1, qb = uid & 63;
                att::attn_unit(F.lds, Qb, Kb, Vb, AO, sinkl, b * S + 64 * qb, kvh, MLAT + b * CL, b * S, qb); }
            if (l == 0 && (F.vcu & 7) == 0) { const int e = F.vcu >> 3; const int b = e >> 3, kvh = (e >> 2) & 1, qb = e & 3;
                att::attn_unit(F.lds, Qb, Kb, Vb, AO, sinkl, MLAT + b * CL + 64 * qb, kvh, MLAT + b * CL, -1, qb); }
            fft::fft_load_tables(F.lds, tabs + TAB_FFT); __syncthreads();
            fft::fft_unit(F.lds, ZT, AO, F.vcu >> 6, F.vcu & 63);
            if (l == 0) { SchedFc Sf{(const char*)(tabs + TAB_DC), (const char*)ZTc, F.vcu}; EpiBf16 Ef{AO, D}; gemm_phase<EpiBf16, SchedFc, 0, false>(F.lds, 512, Sf, Ef); }
        }
        else if constexpr (sub == SUB_OUT) {
            SchedMN Sm{(const char*)AO, wl + W_O, D, nMt, 4, F.G, (int)blockIdx.x}; EpiF32 Ey{Y, D};
            gemm_phase<EpiF32, SchedMN, 0, false>(F.lds, D, Sm, Ey);
        }
        else if constexpr (sub == SUB_POST1 || sub == SUB_POST2) {
            const bool p1 = sub == SUB_POST1; const int nrows = nMt * 256;
            for (int m = gw; m < nrows; m += NGW) {
                const bool lat = m < MLAT; const int r = lat ? (m >> 12) : 4; const float* ml = mod + (size_t)(l * 5 + r) * 6144;
                float* xo = lat ? out + (size_t)m * D : XC + (size_t)(m - MLAT) * D;
                const float* xi = (p1 && l == 0) ? (lat ? x_in + (size_t)m * D : ctx_in + (size_t)(m - MLAT) * D) : xo;
                if (p1) post_row(Y + (size_t)m * D, xi, xo, npo + l * D, ml + 2 * 1024, true, npf + l * D, ml + 3 * 1024, ml + 4 * 1024, XN + (size_t)m * D, F.lane);
                else { const float* ml1 = mod + (size_t)(5 + r) * 6144;
                    post_row(Y + (size_t)m * D, xi, xo, npof + l * D, ml + 5 * 1024, l == 0, npm + D, ml1, ml1 + 1024, XN + (size_t)m * D, F.lane); }
            }
        }
        else if constexpr (sub == SUB_GATEUP) {
            SchedMN Sm{(const char*)XN, wl + W_GU, D, nMt, NGU / 256, F.G, (int)blockIdx.x}; EpiSwiGLU Eg{HID};
            gemm_phase<EpiSwiGLU, SchedMN, 0, true>(F.lds, D, Sm, Eg);
        }
        else if constexpr (sub == SUB_DOWN) {
            SchedMN Sm{(const char*)HID, wl + W_D, FF, nMt, 4, F.G, (int)blockIdx.x}; EpiF32 Ey{Y, D};
            gemm_phase<EpiF32, SchedMN, 0, false>(F.lds, FF, Sm, Ey);
        }
}

__global__ void __launch_bounds__(NWAVES * 64, 2) mk_fwd(Args args) {
    extern __shared__ __attribute__((aligned(16))) unsigned char lds_raw[];
    Frame F; F.lds = (LAS unsigned char*)lds_raw; F.tid = threadIdx.x; F.lane = F.tid & 63; F.wave = __builtin_amdgcn_readfirstlane(F.tid >> 6);
    F.G = gridDim.x; { const int bx = blockIdx.x; F.vcu = (F.G % 8 == 0) ? (bx % 8) * (F.G / 8) + bx / 8 : bx; }
    unsigned char* ws = args.ws;
    const float* x_in = args.in[0]; const float* c_in = args.in[1]; const float* ctx_in = args.in[2]; const float* c_ctx = args.in[3];
    const float* w_ada = args.in[4]; const float* b_ada = args.in[5]; const float* npm = args.in[6]; const float* npo = args.in[7]; const float* npf = args.in[8]; const float* npof = args.in[9];
    const float* w_in = args.in[10]; const float* w_out = args.in[11]; const float* w_four = args.in[12];
    const float* w_gate = args.in[14]; const float* w_up = args.in[15]; const float* w_down = args.in[16];
    float* out = args.out;
    float* mod = (float*)(ws + WS_CTL + CTL_MOD_OFF);
    unsigned char* tabs = ws + WS_TAB; float* rope = (float*)(tabs + TAB_ROPE);
    bf16_t* XN = (bf16_t*)(ws + WS_XN); bf16_t* Qb = (bf16_t*)(ws + WS_Q); bf16_t* Kb = (bf16_t*)(ws + WS_K); bf16_t* Vb = (bf16_t*)(ws + WS_V);
    bf16_t* ZT = (bf16_t*)(ws + WS_ZT); bf16_t* ZTc = (bf16_t*)(ws + WS_ZTC); bf16_t* AO = (bf16_t*)(ws + WS_AO); bf16_t* HID = (bf16_t*)(ws + WS_HID);
    float* Y = (float*)(ws + WS_Y); float* XC = (float*)(ws + WS_XC);
    const int lo = args.ph_lo, hi = args.ph_hi;
    const int gw = F.vcu * NWAVES + F.wave, NGW = F.G * NWAVES;
    Ctx c; c.F = F; c.ws = ws; c.in = nullptr; c.out = out; c.x_in = x_in; c.c_in = c_in; c.ctx_in = ctx_in; c.c_ctx = c_ctx; c.w_ada = w_ada; c.b_ada = b_ada; c.npm = npm; c.npo = npo; c.npf = npf; c.npof = npof;
    c.w_in = w_in; c.w_out = w_out; c.w_four = w_four; c.w_gate = w_gate; c.w_up = w_up; c.w_down = w_down; c.sink = args.in[13]; c.mod = mod; c.rope = rope; c.Y = Y; c.XC = XC; c.tabs = tabs;
    c.XN = XN; c.Qb = Qb; c.Kb = Kb; c.Vb = Vb; c.ZT = ZT; c.ZTc = ZTc; c.AO = AO; c.HID = HID; c.gw = gw; c.NGW = NGW;
    for (int u = F.tid; u < (LDS_BYTES - LDSCTL_OFF) / 4; u += NWAVES * 64) ((LAS unsigned*)(F.lds + LDSCTL_OFF))[u] = 0u;
    __syncthreads();
    XcdBarrier bar; bar.bar = (unsigned*)(ws + WS_CTL) + CW_BAR; bar.x = 0; bar.st = nullptr;
    if (hi - lo > 1) bar = xcd_barrier_post((unsigned*)(ws + WS_CTL) + CW_BAR, (volatile LAS unsigned*)(F.lds + MISC_OFF) + 8);

#define MK_PHASE(PH) if (lo <= (PH) && (PH) < hi) { run_phase<PH>(c); if ((PH) + 1 < hi) xcd_barrier(bar); }
    MK_PHASE(0)
    MK_PHASE(1)
    MK_PHASE(2)
    MK_PHASE(3)
    MK_PHASE(4)
    MK_PHASE(5)
    MK_PHASE(6)
    MK_PHASE(7)
    MK_PHASE(8)
    MK_PHASE(9)
    MK_PHASE(10)
    MK_PHASE(11)
    MK_PHASE(12)
    MK_PHASE(13)
    MK_PHASE(14)
    MK_PHASE(15)
#undef MK_PHASE
}
}

extern "C" void kernel_launch(void* const* d_in, const int* in_sizes, int n_in, void* d_out, int out_size, void* d_ws, size_t ws_size, hipStream_t stream) {
    static int grid = 0;
    if (grid == 0) {
        int dev = 0, cus = 0, per_cu = 0;
        if (hipGetDevice(&dev) != hipSuccess || hipDeviceGetAttribute(&cus, hipDeviceAttributeMultiprocessorCount, dev) != hipSuccess) { grid = -1; }
        else if (hipFuncSetAttribute((const void*)mk::mk_fwd, hipFuncAttributeMaxDynamicSharedMemorySize, mk::LDS_BYTES) != hipSuccess) { grid = -1; }
        else { if (hipOccupancyMaxActiveBlocksPerMultiprocessor(&per_cu, (const void*)mk::mk_fwd, mk::NWAVES * 64, mk::LDS_BYTES) != hipSuccess) per_cu = 0;
               (void)hipGetLastError();
               grid = (per_cu >= 1 && cus >= 256) ? 256 : -1; }
        if (grid < 0) fprintf(stderr, "kernel_launch: needs 256 CUs with one resident 512-thread workgroup each (cus %d, per_cu %d); nothing launched\n", cus, per_cu);
    }
    if (grid < 0) return;
    if (hipMemsetAsync((char*)d_ws + mk::WS_CTL, 0, mk::CTL_ZERO_BYTES, stream) != hipSuccess) return;
    mk::Args a{};
    for (int i = 0; i < 17; ++i) a.in[i] = (const float*)d_in[i];
    a.out = (float*)d_out; a.ws = (unsigned char*)d_ws; a.xsrc = nullptr; a.xcsrc = nullptr; a.layer = 0; a.pad = 0;
#ifndef MK_N_LAUNCHES
#define MK_N_LAUNCHES 1
#endif
#if MK_N_LAUNCHES == 1
    a.ph_lo = 0; a.ph_hi = mk::N_PHASES;
    hipLaunchKernelGGL(mk::mk_fwd, dim3(grid), dim3(mk::NWAVES * 64), mk::LDS_BYTES, stream, a);
#else
    for (int ph = 0; ph < mk::N_PHASES; ++ph) { a.ph_lo = ph; a.ph_hi = ph + 1; hipLaunchKernelGGL(mk::mk_fwd, dim3(grid), dim3(mk::NWAVES * 64), mk::LDS_BYTES, stream, a); }
#endif
}
```

```cpp
#include <hip/hip_runtime.h>
#include <cstdint>
#include <cstdio>
#define MK_N_LAUNCHES 1
#define MK_DUPMASK 0
#define MK_P0PROBE 0
namespace mk {
#define LAS __attribute__((address_space(3)))
#define GAS __attribute__((address_space(1)))
typedef unsigned short bf16_t;
typedef short bf16x8 __attribute__((ext_vector_type(8)));
typedef float f32x4 __attribute__((ext_vector_type(4)));
typedef float f32x2 __attribute__((ext_vector_type(2)));
typedef float f32x16 __attribute__((ext_vector_type(16)));
typedef unsigned u32x4 __attribute__((ext_vector_type(4)));
typedef unsigned u32x2 __attribute__((ext_vector_type(2)));

constexpr int D = 1024, NB = 4, S = 4096, CL = 256, MLAT = NB * S, MCTX = NB * CL, MT = MLAT + MCTX;
constexpr int NQKV = 768, FF = 2816, NGU = 2 * FF, INW = 1280;
constexpr float C2 = 0.125f * 1.4426950408889634f;
constexpr float RMS_EPS = 1e-6f;
constexpr int NWAVES = 8;
constexpr int BM = 256, BK = 64, HALF = 128, HTB = HALF * BK * 2, STAGE_BYTES = 8 * HTB;

__device__ __forceinline__ int lds_byte(int r, int c) { const int st = (r >> 4) * 2 + (c >> 5), rr = r & 15, cc = c & 31, ob = rr * 64 + cc * 2; return st * 1024 + (ob ^ (((ob >> 9) & 1) << 5)); }
__device__ __forceinline__ void stage_rc(int b, int& R, int& C) { const int st = b / 1024, sb = b % 1024, swz = sb ^ (((sb >> 9) & 1) << 5); R = (st >> 1) * 16 + swz / 64; C = (st & 1) * 32 + (swz % 64) / 2; }
__device__ __forceinline__ int perm32(int rho) { const int n = rho >> 4, i = rho & 15; return 8 * (i >> 2) + 4 * n + (i & 3); }
typedef __bf16 bf16x2_t __attribute__((ext_vector_type(2)));
__device__ __forceinline__ unsigned cvt_pk_bf16(float lo, float hi) { unsigned r; asm volatile("v_cvt_pk_bf16_f32 %0, %1, %2" : "=v"(r) : "v"(lo), "v"(hi)); return r; }
__device__ __forceinline__ unsigned cvtpk_s(float lo, float hi) { const float __attribute__((ext_vector_type(2))) v = {lo, hi}; const bf16x2_t b = __builtin_convertvector(v, bf16x2_t); return __builtin_bit_cast(unsigned, b); }
__device__ __forceinline__ unsigned f2bf(float f) { unsigned u = __builtin_bit_cast(unsigned, f); return (u + 0x7fffu + ((u >> 16) & 1u)) >> 16; }
__device__ __forceinline__ unsigned pk2(float lo, float hi) { return f2bf(lo) | (f2bf(hi) << 16); }
__device__ __forceinline__ float bf2f(bf16_t v) { return __builtin_bit_cast(float, (unsigned)v << 16); }
__device__ __forceinline__ float wave_sum(float v) {
#pragma unroll
    for (int o = 1; o < 64; o <<= 1) v += __shfl_xor(v, o);
    return v;
}

struct Unit { const char* a; const char* b; int i0, i1, i2, i3; };

template <class Epi, class Sched, int BMAP, bool ALIGN_EPI>
__device__ __forceinline__ void gemm_phase(LAS unsigned char* lds, const int K, const Sched& S, const Epi& E) {
    const int tid = threadIdx.x, wid = __builtin_amdgcn_readfirstlane(tid >> 6), lane = tid & 63, wr = wid >> 2, wc = wid & 3, fr = lane & 15, fq = lane >> 4;
    const int nt = K / BK;
    unsigned voffA[2], voffB[2];
#pragma unroll
    for (int i = 0; i < 2; ++i) { int R, C; stage_rc(tid * 16 + i * 8192, R, C); const int Rb = Epi::PERM ? ((R & ~31) + perm32(R & 31)) : R;
        const int Rm = (BMAP == 1) ? (64 * (Rb & 63) + (Rb >> 6)) : Rb;
        voffA[i] = (unsigned)(R * K + C) * 2u; voffB[i] = (unsigned)(Rm * K + C) * 2u; }
    const size_t kstep = (size_t)(BK * 2);
    const size_t hstepA = (size_t)HALF * K * 2;
    const size_t hstepB = (BMAP == 1) ? (size_t)2 * K * 2 : (size_t)HALF * K * 2;
    const unsigned ldsw = (unsigned)wid * 1024u;
    const int aoff = lds_byte(wr * 64 + fr, fq * 8), boff = lds_byte(wc * 32 + fr, fq * 8);
#define PG8_SA(b, h) (((b) * 2 + (h)) * HTB)
#define PG8_SB(b, h) ((4 + (b) * 2 + (h)) * HTB)
#define PG8_STAGE(bufoff, gbase, voff) do { _Pragma("unroll") for (int _i = 0; _i < 2; ++_i) \
        __builtin_amdgcn_global_load_lds((const unsigned*)((const char*)(gbase) + (voff)[_i]), (LAS unsigned*)(lds + (bufoff) + ldsw + _i * 8192), 16, 0, 0); } while (0)
#define PG8_LDA(dst, b, h) do { _Pragma("unroll") for (int m = 0; m < 4; ++m) _Pragma("unroll") for (int k = 0; k < 2; ++k) dst[m][k] = *(const LAS bf16x8*)(lds + PG8_SA(b, h) + aoff + m * 2048 + k * 1024); } while (0)
#define PG8_LDB(dst, b, h) do { _Pragma("unroll") for (int n = 0; n < 2; ++n) _Pragma("unroll") for (int k = 0; k < 2; ++k) dst[n][k] = *(const LAS bf16x8*)(lds + PG8_SB(b, h) + boff + n * 2048 + k * 1024); } while (0)
#define PG8_MMA(ai, bj, At, Bt) do { __builtin_amdgcn_s_setprio(1); _Pragma("unroll") for (int m = 0; m < 4; ++m) _Pragma("unroll") for (int n = 0; n < 2; ++n) _Pragma("unroll") for (int k = 0; k < 2; ++k) \
        acc[ai][bj][m][n] = __builtin_amdgcn_mfma_f32_16x16x32_bf16(Bt[n][k], At[m][k], acc[ai][bj][m][n], 0, 0, 0); __builtin_amdgcn_s_setprio(0); } while (0)
#define PG8_WAIT_V(n) asm volatile("s_waitcnt vmcnt(" #n ")" ::: "memory")
#define PG8_WAIT_L(n) asm volatile("s_waitcnt lgkmcnt(" #n ")" ::: "memory")
#define PG8_BAR __builtin_amdgcn_s_barrier()
#define PG8_SCHED __builtin_amdgcn_sched_barrier(0)
    Unit cur, nxt; int ui = 0;
    if (!S.next(0, cur)) return;
    f32x4 acc[2][2][4][2];
#pragma unroll
    for (int a = 0; a < 2; ++a)
#pragma unroll
        for (int b = 0; b < 2; ++b)
#pragma unroll
            for (int m = 0; m < 4; ++m)
#pragma unroll
                for (int n = 0; n < 2; ++n) acc[a][b][m][n] = (f32x4){0.f, 0.f, 0.f, 0.f};
    bf16x8 At[4][2], B0[2][2], B1[2][2];
    const char* cA = cur.a; const char* cB = cur.b;
    PG8_STAGE(PG8_SB(0, 0), cB, voffB); PG8_STAGE(PG8_SB(0, 1), cB + hstepB, voffB); PG8_STAGE(PG8_SA(0, 0), cA, voffA); PG8_STAGE(PG8_SA(0, 1), cA + hstepA, voffA);
    if (wr == 1) PG8_BAR;
    PG8_WAIT_V(2); PG8_BAR;
    PG8_STAGE(PG8_SB(1, 0), cB + kstep, voffB); PG8_STAGE(PG8_SA(1, 0), cA + kstep, voffA); PG8_STAGE(PG8_SB(1, 1), cB + hstepB + kstep, voffB);
    PG8_WAIT_V(6); PG8_BAR;
    for (;;) {
        const bool has_next = S.next(ui + 1, nxt);
        const char* nA = has_next ? nxt.a : cA; const char* nB = has_next ? nxt.b : cB;
        for (int t = 0; t < nt; t += 2) {
            const bool last = (t == nt - 2);
            const char* a1 = cA + (size_t)(t + 1) * kstep;
            const char* a2 = last ? nA : cA + (size_t)(t + 2) * kstep; const char* b2 = last ? nB : cB + (size_t)(t + 2) * kstep;
            const char* a3 = a2 + kstep; const char* b3 = b2 + kstep;
            PG8_LDB(B0, 0, 0); PG8_LDB(B1, 0, 1); PG8_SCHED; PG8_LDA(At, 0, 0); PG8_STAGE(PG8_SA(1, 1), a1 + hstepA, voffA);
            PG8_WAIT_V(8); PG8_WAIT_L(0); PG8_BAR; PG8_MMA(0, 0, At, B0); PG8_MMA(0, 1, At, B1); PG8_BAR; PG8_SCHED;
            PG8_LDA(At, 0, 1); PG8_STAGE(PG8_SB(0, 0), b2, voffB); PG8_STAGE(PG8_SB(0, 1), b2 + hstepB, voffB); PG8_STAGE(PG8_SA(0, 0), a2, voffA);
            PG8_WAIT_V(8); PG8_WAIT_L(0); PG8_BAR; PG8_MMA(1, 0, At, B0); PG8_MMA(1, 1, At, B1); PG8_BAR; PG8_SCHED;
            PG8_LDB(B0, 1, 0); PG8_LDB(B1, 1, 1); PG8_SCHED; PG8_LDA(At, 1, 0); PG8_STAGE(PG8_SA(0, 1), a2 + hstepA, voffA);
            PG8_WAIT_V(8); PG8_WAIT_L(0); PG8_BAR; PG8_MMA(0, 0, At, B0); PG8_MMA(0, 1, At, B1); PG8_BAR; PG8_SCHED;
            PG8_LDA(At, 1, 1); PG8_STAGE(PG8_SB(1, 0), b3, voffB); PG8_STAGE(PG8_SB(1, 1), b3 + hstepB, voffB); PG8_STAGE(PG8_SA(1, 0), a3, voffA);
            PG8_WAIT_V(8); PG8_WAIT_L(0); PG8_BAR; PG8_MMA(1, 0, At, B0); PG8_MMA(1, 1, At, B1); PG8_BAR; PG8_SCHED;
        }
        if constexpr (ALIGN_EPI) { if (wr == 0) PG8_BAR; }
        if constexpr (!Epi::AFTER_DRAIN) { E(acc, cur, wr, wc, fr, fq); }
        if (!has_next) break;
#pragma unroll
        for (int a = 0; a < 2; ++a)
#pragma unroll
            for (int b = 0; b < 2; ++b)
#pragma unroll
                for (int m = 0; m < 4; ++m)
#pragma unroll
                    for (int n = 0; n < 2; ++n) acc[a][b][m][n] = (f32x4){0.f, 0.f, 0.f, 0.f};
        cur = nxt; cA = nA; cB = nB; ++ui;
        if constexpr (ALIGN_EPI) { if (wr == 1) PG8_BAR; }
    }
    PG8_WAIT_V(0);
    if constexpr (!ALIGN_EPI) { if (wr == 0) PG8_BAR; }
    PG8_BAR;
    if constexpr (Epi::AFTER_DRAIN) { E.fused(acc, cur, wr, wc, fr, fq, lds, wid, lane); }
#undef PG8_SA
#undef PG8_SB
#undef PG8_STAGE
#undef PG8_LDA
#undef PG8_LDB
#undef PG8_MMA
#undef PG8_WAIT_V
#undef PG8_WAIT_L
#undef PG8_BAR
#undef PG8_SCHED
}
constexpr size_t MiB = 1u << 20;
#ifndef MK_WS_MAP_HYBRID
#define MK_WS_MAP_HYBRID 0
#endif
constexpr size_t WS_CTL = 0, CTL_ZERO_BYTES = 1 * MiB;
constexpr size_t CTL_MOD_OFF = 512 * 1024;
constexpr size_t W_QKV = 0, W_Z = 1536 * 1024, W_O = W_Z + 2 * MiB, W_GU = W_O + 2 * MiB, W_D = W_GU + 11 * MiB, W_LAYER = 22 * MiB;
#if MK_WS_MAP_HYBRID
constexpr size_t WS_TAB = 6 * MiB;
constexpr size_t WS_ZT = 8 * MiB, WS_ZTC = 40 * MiB;
constexpr size_t WS_XN = 161 * MiB;
constexpr size_t WS_Q = 195 * MiB, WS_K = 212 * MiB, WS_V = WS_K + 4352 * 1024;
constexpr size_t WS_W = 229 * MiB;
constexpr size_t W_LSTRIDE = 4 * MiB;
constexpr size_t WS_AO = 76 * MiB;
#else
constexpr size_t WS_TAB = 1 * MiB;
constexpr size_t WS_W = 2 * MiB; constexpr size_t W_LSTRIDE = W_LAYER;
constexpr size_t WS_XN = 46 * MiB;
constexpr size_t WS_Q = 80 * MiB, WS_K = 97 * MiB, WS_V = WS_K + 4352 * 1024, WS_ZT = WS_V + 4352 * 1024, WS_ZTC = WS_ZT + 32 * MiB, WS_AO = WS_ZTC + 2 * MiB;
constexpr size_t WS_HID = 80 * MiB;
constexpr size_t WS_Y = 174 * MiB;
constexpr size_t WS_XC = 242 * MiB;
#endif
constexpr size_t TAB_ROPE = 0;

struct Args {
    const float* in[17]; float* out; unsigned char* ws;
    const float* xsrc; const float* xcsrc;
    int ph_lo, ph_hi, layer, pad;
};

struct Frame {
    LAS unsigned char* lds;
    int tid, lane, wave, vcu, G;
};

__device__ __forceinline__ void p0_tr_item(const float* W, int pitch, int k0, int n0src, bf16_t* WT, int K, int drow0, LAS float* scr, int lane) {
#pragma unroll 8
    for (int i = 0; i < 32; ++i) { const int kk = 2 * i + (lane >> 5); scr[kk * 33 + (lane & 31)] = W[(size_t)(k0 + kk) * pitch + n0src + (lane & 31)]; }
    asm volatile("s_waitcnt lgkmcnt(0)" ::: "memory");
    const int c = lane & 7;
#pragma unroll
    for (int j = 0; j < 4; ++j) { const int n = (lane >> 3) + 8 * j; const LAS float* s = scr + (8 * c) * 33 + n;
        u32x4 o; o.x = pk2(s[0 * 33], s[1 * 33]); o.y = pk2(s[2 * 33], s[3 * 33]); o.z = pk2(s[4 * 33], s[5 * 33]); o.w = pk2(s[6 * 33], s[7 * 33]);
        *(u32x4*)(WT + (size_t)(drow0 + n) * K + k0 + 8 * c) = o; }
    asm volatile("s_waitcnt lgkmcnt(0)" ::: "memory");
}

__device__ __forceinline__ void p0_foldM_item(const float* wf_lg, float* M, int type, LAS float* tb, int lane) {
    { float s, c; sincospif((float)lane / 32.0f, &s, &c); tb[lane] = type == 0 ? c : s; }
    float wfr[64];
#pragma unroll
    for (int cp = 0; cp < 64; ++cp) wfr[cp] = wf_lg[cp * 64 + lane];
    asm volatile("s_waitcnt lgkmcnt(0)" ::: "memory");
    for (int c = 0; c < 64; ++c) { float a0 = 0.f, a1 = 0.f;
#pragma unroll
        for (int cp = 0; cp < 64; cp += 2) { a0 += tb[(c * cp) & 63] * wfr[cp]; a1 += tb[(c * (cp + 1)) & 63] * wfr[cp + 1]; }
        M[c * 64 + lane] = (a0 + a1) * (1.0f / 512.0f); }
    asm volatile("s_waitcnt lgkmcnt(0)" ::: "memory");
}
__device__ __forceinline__ void p0_fold_item(const float* w_in_l, const float* M, bf16_t* WZ, int type, int g, int k0, LAS float* scr, int lane) {
    float mr[64];
#pragma unroll
    for (int c = 0; c < 64; ++c) mr[c] = M[c * 64 + lane];
    { const float* wrow = w_in_l + (size_t)(k0 + (lane >> 2)) * INW + 768 + g * 64 + (lane & 3) * 16;
#pragma unroll
      for (int j = 0; j < 4; ++j) *(LAS f32x4*)(scr + (lane >> 2) * 64 + (lane & 3) * 16 + 4 * j) = *(const f32x4*)(wrow + 4 * j); }
    asm volatile("s_waitcnt lgkmcnt(0)" ::: "memory");
    bf16_t* orow = WZ + (size_t)(type * 512 + g * 64 + lane) * D + k0;
#pragma unroll 1
    for (int k = 0; k < 16; k += 2) { float a0 = 0.f, a1 = 0.f;
#pragma unroll
        for (int c4 = 0; c4 < 16; ++c4) { const f32x4 w0 = *(const LAS f32x4*)(scr + k * 64 + 4 * c4), w1 = *(const LAS f32x4*)(scr + (k + 1) * 64 + 4 * c4);
            a0 += (w0[0] * mr[4 * c4] + w0[1] * mr[4 * c4 + 1]) + (w0[2] * mr[4 * c4 + 2] + w0[3] * mr[4 * c4 + 3]);
            a1 += (w1[0] * mr[4 * c4] + w1[1] * mr[4 * c4 + 1]) + (w1[2] * mr[4 * c4 + 2] + w1[3] * mr[4 * c4 + 3]); }
        *(unsigned*)(orow + k) = pk2(a0, a1); }
    asm volatile("s_waitcnt lgkmcnt(0)" ::: "memory");
}

__device__ __forceinline__ void p0_adaln_item(const float* c, const float* c_ctx, const float* w_ada, const float* b_ada, float* mod, int l, int cb, int ks, LAS float* sv, int lane) {
    const int col0 = cb * 256 + lane * 4;
    for (int e = lane; e < 160; e += 64) { const int r = e >> 5, k = ks * 32 + (e & 31); const float v = r < 4 ? c[r * 1024 + k] : c_ctx[k]; sv[e] = v / (1.0f + __expf(-v)); }
    f32x4 w[32];
    const float* wp = w_ada + ((size_t)l * 1024 + ks * 32) * 6144 + col0;
#pragma unroll
    for (int kk = 0; kk < 32; ++kk) w[kk] = *(const f32x4*)(wp + (size_t)kk * 6144);
    asm volatile("s_waitcnt lgkmcnt(0)" ::: "memory");
    f32x4 acc[5];
#pragma unroll
    for (int r = 0; r < 5; ++r) acc[r] = (f32x4){0.f, 0.f, 0.f, 0.f};
#pragma unroll
    for (int kk = 0; kk < 32; ++kk)
#pragma unroll
        for (int r = 0; r < 5; ++r) acc[r] += sv[r * 32 + kk] * w[kk];
    if (ks == 0) { const f32x4 b = *(const f32x4*)(b_ada + l * 6144 + col0);
#pragma unroll
        for (int r = 0; r < 5; ++r) acc[r] += b; }
#pragma unroll
    for (int r = 0; r < 5; ++r)
#pragma unroll
        for (int j = 0; j < 4; ++j) atomicAdd(mod + (size_t)(l * 5 + r) * 6144 + col0 + j, acc[r][j]);
    asm volatile("s_waitcnt lgkmcnt(0)" ::: "memory");
}

__device__ __forceinline__ void normmod_row(const float* xrow, const float* gain, const float* sh, const float* sc, bf16_t* orow, int lane) {
    f32x4 v[4]; float ss = 0.f;
#pragma unroll
    for (int j = 0; j < 4; ++j) { v[j] = *(const f32x4*)(xrow + lane * 4 + 256 * j); ss += (v[j][0] * v[j][0] + v[j][1] * v[j][1]) + (v[j][2] * v[j][2] + v[j][3] * v[j][3]); }
    const float rs = rsqrtf(wave_sum(ss) * (1.0f / D) + RMS_EPS);
#pragma unroll
    for (int j = 0; j < 4; ++j) { const int idx = lane * 4 + 256 * j; const f32x4 g = *(const f32x4*)(gain + idx), a = *(const f32x4*)(sc + idx), b = *(const f32x4*)(sh + idx);
        const f32x4 o = v[j] * rs * g * (1.0f + a) + b;
        u32x2 w; w.x = pk2(o[0], o[1]); w.y = pk2(o[2], o[3]); *(u32x2*)(orow + idx) = w; }
}

struct SchedZ { const char* WZ; const char* XN; int vcu;
    __device__ __forceinline__ bool next(int i, Unit& u) const { if (i > 0) return false; const int x = vcu >> 5, q = vcu & 31; const int tt = 8 * x + (q >> 2), zp = q & 3;
        u.a = WZ + (size_t)zp * 256 * D * 2; u.b = XN + ((size_t)(tt >> 4) * S + 4 * (tt & 15)) * D * 2; u.i0 = tt; u.i1 = zp; u.i2 = 0; u.i3 = 0; return true; } };
struct SchedQKV { const char* XN; const char* W; int vcu; int full_ctx;
    __device__ __forceinline__ bool next(int i, Unit& u) const { if (i > 0) return false; const int x = vcu >> 5, q = vcu & 31; int tile, pn;
        if (q < 24) { tile = 8 * x + q / 3; pn = q % 3; }
        else { const int e = x * 8 + (q - 24); if (full_ctx) { if (e >= 12) return false; tile = 64 + e / 3; pn = e % 3; } else { if (e >= 4) return false; tile = 64 + e; pn = 2; } }
        u.a = XN + (size_t)tile * 256 * D * 2; u.b = W + (size_t)pn * 256 * D * 2; u.i0 = tile; u.i1 = pn; u.i2 = 0; u.i3 = 0; return true; } };
struct SchedZc { const char* WZ; const char* XN; int vcu;
    __device__ __forceinline__ bool next(int i, Unit& u) const { if (i > 0) return false; const int x = vcu >> 5, q = vcu & 31; if (q < 24) return false; const int e = x * 8 + (q - 24) - 12; if (e < 0 || e >= 16) return false;
        const int cb = e >> 2, zp = e & 3; u.a = WZ + (size_t)zp * 256 * D * 2; u.b = XN + ((size_t)MLAT + cb * 256) * D * 2; u.i0 = cb; u.i1 = zp; u.i2 = 0; u.i3 = 0; return true; } };

struct EpiQKV {
    static constexpr bool PERM = true, AFTER_DRAIN = false;
    bf16_t* Q; bf16_t* Kb; bf16_t* Vb; const float* rope;
    __device__ __forceinline__ void operator()(const f32x4 (&acc)[2][2][4][2], const Unit& u, int wr, int wc, int fr, int fq) const {
        const int tile = u.i0, pn = u.i1; const bool lat = tile < 64;
#pragma unroll
        for (int ai = 0; ai < 2; ++ai)
#pragma unroll
            for (int m = 0; m < 4; ++m) { const int row = tile * 256 + ai * HALF + wr * 64 + m * 16 + fr; const int t = row & (S - 1), gr = t >> 6, gc = t & 63;
#pragma unroll
                for (int bj = 0; bj < 2; ++bj) { const int colt = bj * HALF + wc * 32 + 8 * fq; f32x4 v0 = acc[ai][bj][m][0], v1 = acc[ai][bj][m][1];
                    const bool isV = (pn == 2) && (bj == 1);
                    if (lat && !isV) { const int i0 = (colt & 63) >> 1; const int pos = i0 < 16 ? gr : gc; const f32x4* tp = (const f32x4*)(rope + (size_t)(pos * 16 + (i0 & 15)) * 2);
                        const f32x4 c01 = tp[0], c23 = tp[1];
                        v0 = (f32x4){v0[0] * c01[0] - v0[1] * c01[1], v0[0] * c01[1] + v0[1] * c01[0], v0[2] * c01[2] - v0[3] * c01[3], v0[2] * c01[3] + v0[3] * c01[2]};
                        v1 = (f32x4){v1[0] * c23[0] - v1[1] * c23[1], v1[0] * c23[1] + v1[1] * c23[0], v1[2] * c23[2] - v1[3] * c23[3], v1[2] * c23[3] + v1[3] * c23[2]}; }
                    bf16_t* dst;
                    if (pn < 2) { v0 = v0 * C2; v1 = v1 * C2; dst = Q + (size_t)row * 512 + pn * 256 + colt; }
                    else if (bj == 0) dst = Kb + (size_t)row * 128 + colt;
                    else dst = Vb + (size_t)row * 128 + (colt - 128);
                    u32x4 w; w.x = cvt_pk_bf16(v0[0], v0[1]); w.y = cvt_pk_bf16(v0[2], v0[3]); w.z = cvt_pk_bf16(v1[0], v1[1]); w.w = cvt_pk_bf16(v1[2], v1[3]);
                    *(u32x4*)dst = w; } }
    }
};
struct EpiZ {
    static constexpr bool PERM = true, AFTER_DRAIN = false;
    bf16_t* ZT;
    __device__ __forceinline__ void operator()(const f32x4 (&acc)[2][2][4][2], const Unit& u, int wr, int wc, int fr, int fq) const {
        const int tt = u.i0, zp = u.i1, b = tt >> 4, n2_0 = (tt & 15) * 4, type = zp >> 1;
#pragma unroll
        for (int ai = 0; ai < 2; ++ai)
#pragma unroll
            for (int m = 0; m < 4; ++m) { const int ch = (zp & 1) * 256 + ai * HALF + wr * 64 + m * 16 + fr; bf16_t* base = ZT + (((size_t)ch * 4 + b) * 2 + type) * 4096;
#pragma unroll
                for (int bj = 0; bj < 2; ++bj) { const int j = bj * HALF + wc * 32 + 8 * fq; const int n2 = n2_0 + (j >> 6), n1 = j & 63; const f32x4 v0 = acc[ai][bj][m][0], v1 = acc[ai][bj][m][1];
                    u32x4 w; w.x = cvt_pk_bf16(v0[0], v0[1]); w.y = cvt_pk_bf16(v0[2], v0[3]); w.z = cvt_pk_bf16(v1[0], v1[1]); w.w = cvt_pk_bf16(v1[2], v1[3]);
                    *(u32x4*)(base + n2 * 64 + n1) = w; } }
    }
};
struct EpiZc {
    static constexpr bool PERM = true, AFTER_DRAIN = false;
    bf16_t* ZTc;
    __device__ __forceinline__ void operator()(const f32x4 (&acc)[2][2][4][2], const Unit& u, int wr, int wc, int fr, int fq) const {
        const int b = u.i0, zp = u.i1, type = zp >> 1;
#pragma unroll
        for (int ai = 0; ai < 2; ++ai)
#pragma unroll
            for (int m = 0; m < 4; ++m) { const int ch = (zp & 1) * 256 + ai * HALF + wr * 64 + m * 16 + fr; bf16_t* base = ZTc + (((size_t)b * 512 + ch) * 2 + type) * 256;
#pragma unroll
                for (int bj = 0; bj < 2; ++bj) { const int j = bj * HALF + wc * 32 + 8 * fq; const f32x4 v0 = acc[ai][bj][m][0], v1 = acc[ai][bj][m][1];
                    u32x4 w; w.x = cvt_pk_bf16(v0[0], v0[1]); w.y = cvt_pk_bf16(v0[2], v0[3]); w.z = cvt_pk_bf16(v1[0], v1[1]); w.w = cvt_pk_bf16(v1[2], v1[3]);
                    *(u32x4*)(base + j) = w; } }
    }
};
namespace att {
constexpr int KT_BYTES = 8192, BUF_BYTES = 2 * KT_BYTES, LDS_WS = 2 * BUF_BYTES;
constexpr int LDS_BYTES_ATT = LDS_WS + 8 * 256;
__device__ __forceinline__ int crow(int r, int hi) { return (r & 3) + 8 * (r >> 2) + 4 * hi; }
typedef short s16x4 __attribute__((ext_vector_type(4)));
__device__ __forceinline__ s16x4 vtr(const LAS unsigned char* p) { return __builtin_bit_cast(s16x4, __builtin_amdgcn_ds_read_tr16_b64_v4i16((LAS s16x4*)p)); }
__device__ __forceinline__ void hswap(unsigned& a, unsigned& b) { asm volatile("s_nop 1\n\tv_permlane32_swap_b32 %0, %1" : "+v"(a), "+v"(b)); }
__device__ __forceinline__ float hswap_max(float v) { unsigned a = __builtin_bit_cast(unsigned, v), b = a; hswap(a, b); return fmaxf(__builtin_bit_cast(float, a), __builtin_bit_cast(float, b)); }
__device__ __forceinline__ float hswap_sum(float v) { unsigned a = __builtin_bit_cast(unsigned, v), b = a; hswap(a, b); return __builtin_bit_cast(float, a) + __builtin_bit_cast(float, b); }

__device__ __forceinline__ void attn_unit(LAS unsigned char* lds, const bf16_t* Q, const bf16_t* Kb, const bf16_t* Vb, bf16_t* AO, const float* sinkl,
                                          int qrow0, int kvh, int krow_ctx, int krow_lat, int qb) {
    const int tid = threadIdx.x, lane = tid & 63, r32 = lane & 31, hi = lane >> 5; const int wid = __builtin_amdgcn_readfirstlane(tid >> 6);
    const int g = wid >> 1, half = wid & 1, h = kvh * 4 + g;
    LAS float* wsf = (LAS float*)(lds + LDS_WS) + wid * 64;
    int jlo = 0, jhi = -1;
    if (krow_lat >= 0) { jlo = qb - 2 < 0 ? 0 : qb - 2; jhi = qb + 2 > 63 ? 63 : qb + 2; }
    const int NT = 4 + (jhi - jlo + 1);
    const bf16_t* Qw = Q + (size_t)(qrow0 + 32 * half + r32) * 512 + h * 64;
    bf16x8 qr[4];
#pragma unroll
    for (int d0 = 0; d0 < 4; ++d0) qr[d0] = *(const bf16x8*)(Qw + d0 * 16 + hi * 8);
    const int krow_of_lane = lane, vrow_of_lane = 16 * (wid & 3) + (lane >> 2);
    const size_t koff = (size_t)krow_of_lane * 128 + kvh * 64 + wid * 8;
    const size_t voff = (size_t)vrow_of_lane * 128 + kvh * 64 + (wid >> 2) * 32 + (lane & 3) * 8;
    const int sdst = wid * 1024 + lane * 16;
    auto tile_row = [&](int t) -> int { return t < 4 ? krow_ctx + 64 * t : krow_lat + 64 * (jlo + t - 4); };
    u32x4 kreg, vreg;
    { const int kr = tile_row(0); kreg = *(const u32x4*)(Kb + (size_t)kr * 128 + koff); vreg = *(const u32x4*)(Vb + (size_t)kr * 128 + voff); }
    *(LAS u32x4*)(lds + sdst) = kreg; *(LAS u32x4*)(lds + KT_BYTES + sdst) = vreg;
    __syncthreads();
    float m_run = -1e30f, l_run = 0.f;
    f32x16 o0 = {}, o1 = {};
    const int qtok = 64 * qb + 32 * half + r32;
    for (int t = 0; t < NT; ++t) {
        const LAS unsigned char* kb_ = lds + (t & 1) * BUF_BYTES; const LAS unsigned char* vb_ = kb_ + KT_BYTES;
        if (t + 1 < NT) { const int kr = tile_row(t + 1); kreg = *(const u32x4*)(Kb + (size_t)kr * 128 + koff); vreg = *(const u32x4*)(Vb + (size_t)kr * 128 + voff); }
        f32x16 p0 = {}, p1 = {};
        { const LAS unsigned char* kp = kb_ + hi * 1024 + r32 * 16;
#pragma unroll
          for (int d0 = 0; d0 < 4; ++d0) { const bf16x8 a0 = *(const LAS bf16x8*)(kp + d0 * 2048), a1 = *(const LAS bf16x8*)(kp + d0 * 2048 + 512);
              p0 = __builtin_amdgcn_mfma_f32_32x32x16_bf16(a0, qr[d0], p0, 0, 0, 0); p1 = __builtin_amdgcn_mfma_f32_32x32x16_bf16(a1, qr[d0], p1, 0, 0, 0); } }
        if (t >= 4) { const int jt = jlo + t - 4; const int dq = jt - qb;
            if (dq == 2 || dq == -2) { const int kbase = 64 * jt + 4 * hi - qtok;
#pragma unroll
                for (int r = 0; r < 16; ++r) { const int dj = kbase + (r & 3) + 8 * (r >> 2);
                    if (dj < -128 || dj > 128) p0[r] = -1e30f; if (dj + 32 < -128 || dj + 32 > 128) p1[r] = -1e30f; } } }
        float mx = fmaxf(p0[0], p1[0]);
#pragma unroll
        for (int r = 1; r < 16; ++r) mx = fmaxf(mx, fmaxf(p0[r], p1[r]));
        mx = hswap_max(mx);
        const float mnew = fmaxf(m_run, mx); const float alpha = __builtin_amdgcn_exp2f(m_run - mnew); m_run = mnew;
        float ps = 0.f;
#pragma unroll
        for (int r = 0; r < 16; ++r) { p0[r] = __builtin_amdgcn_exp2f(p0[r] - mnew); p1[r] = __builtin_amdgcn_exp2f(p1[r] - mnew); ps += p0[r] + p1[r]; }
        l_run = l_run * alpha + ps;
        if (hi == 0) wsf[r32] = alpha;
        asm volatile("s_waitcnt lgkmcnt(0)" ::: "memory");
#pragma unroll
        for (int r = 0; r < 16; ++r) { const float f = wsf[crow(r, hi)]; o0[r] *= f; o1[r] *= f; }
        u32x4 pa[4];
#pragma unroll
        for (int s = 0; s < 2; ++s) {
            pa[s]     = (u32x4){cvtpk_s(p0[8 * s], p0[8 * s + 1]), cvtpk_s(p0[8 * s + 2], p0[8 * s + 3]), cvtpk_s(p0[8 * s + 4], p0[8 * s + 5]), cvtpk_s(p0[8 * s + 6], p0[8 * s + 7])};
            pa[2 + s] = (u32x4){cvtpk_s(p1[8 * s], p1[8 * s + 1]), cvtpk_s(p1[8 * s + 2], p1[8 * s + 3]), cvtpk_s(p1[8 * s + 4], p1[8 * s + 5]), cvtpk_s(p1[8 * s + 6], p1[8 * s + 7])}; }
        { const LAS unsigned char* vp = vb_ + ((lane >> 4) & 1) * 32 + (lane & 3) * 8 + (4 * hi + ((lane & 15) >> 2)) * 64;
#pragma unroll
          for (int ks = 0; ks < 4; ++ks) {
              const s16x4 l0 = vtr(vp + ks * 1024), h0 = vtr(vp + ks * 1024 + 512), l1 = vtr(vp + 4096 + ks * 1024), h1 = vtr(vp + 4096 + ks * 1024 + 512);
              const bf16x8 v0 = (bf16x8){l0[0], l0[1], l0[2], l0[3], h0[0], h0[1], h0[2], h0[3]}, v1 = (bf16x8){l1[0], l1[1], l1[2], l1[3], h1[0], h1[1], h1[2], h1[3]};
              const bf16x8 pf = __builtin_bit_cast(bf16x8, pa[ks]);
              o0 = __builtin_amdgcn_mfma_f32_32x32x16_bf16(pf, v0, o0, 0, 0, 0); o1 = __builtin_amdgcn_mfma_f32_32x32x16_bf16(pf, v1, o1, 0, 0, 0); } }
        if (t + 1 < NT) { LAS unsigned char* nb = lds + ((t + 1) & 1) * BUF_BYTES; *(LAS u32x4*)(nb + sdst) = kreg; *(LAS u32x4*)(nb + KT_BYTES + sdst) = vreg; }
        __syncthreads();
    }
    float l_tot = hswap_sum(l_run) + __builtin_amdgcn_exp2f(sinkl[h] * 1.4426950408889634f - m_run);
    if (hi == 0) wsf[32 + r32] = 1.0f / l_tot;
    asm volatile("s_waitcnt lgkmcnt(0)" ::: "memory");
    bf16_t* Ow = AO + (size_t)(qrow0 + 32 * half) * D + h * 64 + r32;
#pragma unroll
    for (int r = 0; r < 16; ++r) { const int q = crow(r, hi); const float f = wsf[32 + q];
        Ow[(size_t)q * D] = (bf16_t)f2bf(o0[r] * f); Ow[(size_t)q * D + 32] = (bf16_t)f2bf(o1[r] * f); }
    __syncthreads();
}
}
namespace fft {
constexpr int ROWB = 272;
constexpr int T_M1R = 0, T_M1I = 64 * ROWB, T_M2P = 2 * 64 * ROWB, T_TW = 3 * 64 * ROWB, T_BYTES = T_TW + 1024;
constexpr int L_TAB = 0, L_STG = 53248, LDS_BYTES_FFT = L_STG + 65536;
__device__ __forceinline__ int crow(int r, int hi) { return (r & 3) + 8 * (r >> 2) + 4 * hi; }

__device__ __forceinline__ void gen_table_entry(unsigned char* tab, int e) {
    if (e < 3 * 8192) { const int mat = e >> 13, row = (e >> 7) & 63, col = e & 127; float v;
        if (mat < 2) { const int type = col >> 6, n1 = col & 63; float s, c; sincospif((float)((n1 * row) & 63) / 32.0f, &s, &c);
            v = mat == 0 ? (type == 0 ? c : -s) : (type == 0 ? -s : -c); }
        else {
            const int f = col >> 4, hh = (col >> 3) & 1, j = col & 7, ri = f >> 2, rb = (f >> 1) & 1, s_ = f & 1; const int n2 = 32 * rb + 16 * s_ + 8 * (j >> 2) + 4 * hh + (j & 3);
            float s, c; sincospif((float)((n2 * row) & 63) / 32.0f, &s, &c); v = ri == 0 ? c : s; }
        *(bf16_t*)(tab + mat * 64 * ROWB + row * ROWB + col * 2) = (bf16_t)f2bf(v); }
    else { const int t = e - 3 * 8192; if (t < 128) { float s, c; if (t < 64) sincospif((float)t / 32.0f, &s, &c); else sincospif((float)(t - 64) / 2048.0f, &s, &c);
        float* p = (float*)(tab + T_TW) + 2 * t; p[0] = c; p[1] = s; } }
}

__device__ __forceinline__ void fft_load_tables(LAS unsigned char* lds, const unsigned char* tab) {
    for (int i = threadIdx.x; i < T_BYTES / 16; i += NWAVES * 64) *(LAS u32x4*)(lds + L_TAB + i * 16) = *(const u32x4*)(tab + i * 16);
}

__device__ __forceinline__ void fft_unit(LAS unsigned char* lds, const bf16_t* ZT, bf16_t* AO, int b, int chg) {
    const int tid = threadIdx.x, lane = tid & 63, r32 = lane & 31, hi = lane >> 5; const int wid = __builtin_amdgcn_readfirstlane(tid >> 6);
    const int ch = chg * 8 + wid;
    const bf16_t* zb = ZT + ((size_t)ch * 4 + b) * 2 * 4096;
    const LAS unsigned char* tM1r = lds + L_TAB + T_M1R; const LAS unsigned char* tM1i = lds + L_TAB + T_M1I; const LAS unsigned char* tM2 = lds + L_TAB + T_M2P;
    const LAS f32x2* TH = (const LAS f32x2*)(lds + L_TAB + T_TW); const LAS f32x2* TL = TH + 64;
    f32x16 out[2][2];
#pragma unroll
    for (int a = 0; a < 2; ++a)
#pragma unroll
        for (int c = 0; c < 2; ++c) out[a][c] = (f32x16){};
#pragma unroll
    for (int rb = 0; rb < 2; ++rb) {
        f32x16 Tr[2], Ti[2];
        Tr[0] = (f32x16){}; Tr[1] = (f32x16){}; Ti[0] = (f32x16){}; Ti[1] = (f32x16){};
        bf16x8 xa[8];
#pragma unroll
        for (int ks = 0; ks < 8; ++ks) xa[ks] = *(const bf16x8*)(zb + (size_t)(ks >> 2) * 4096 + (32 * rb + r32) * 64 + 16 * (ks & 3) + 8 * hi);
#pragma unroll
        for (int ks = 0; ks < 8; ++ks) {
#pragma unroll
            for (int cb = 0; cb < 2; ++cb) { const int boff = (32 * cb + r32) * ROWB + (16 * ks + 8 * hi) * 2;
                const bf16x8 br = *(const LAS bf16x8*)(tM1r + boff), bi = *(const LAS bf16x8*)(tM1i + boff);
                Tr[cb] = __builtin_amdgcn_mfma_f32_32x32x16_bf16(xa[ks], br, Tr[cb], 0, 0, 0); Ti[cb] = __builtin_amdgcn_mfma_f32_32x32x16_bf16(xa[ks], bi, Ti[cb], 0, 0, 0); } }
        u32x4 fr_[2][2][2];
#pragma unroll
        for (int cb = 0; cb < 2; ++cb) { const int k1 = 32 * cb + r32; float tr[16], ti[16];
#pragma unroll
            for (int r = 0; r < 16; ++r) { const int n2 = 32 * rb + crow(r, hi); const int m = n2 * k1; const f32x2 a = TH[m >> 6], bb = TL[m & 63];
                const float c = a[0] * bb[0] - a[1] * bb[1], s = a[1] * bb[0] + a[0] * bb[1];
                tr[r] = Tr[cb][r] * c + Ti[cb][r] * s; ti[r] = Ti[cb][r] * c - Tr[cb][r] * s; }
#pragma unroll
            for (int s_ = 0; s_ < 2; ++s_) {
                fr_[0][cb][s_] = (u32x4){cvt_pk_bf16(tr[8 * s_], tr[8 * s_ + 1]), cvt_pk_bf16(tr[8 * s_ + 2], tr[8 * s_ + 3]), cvt_pk_bf16(tr[8 * s_ + 4], tr[8 * s_ + 5]), cvt_pk_bf16(tr[8 * s_ + 6], tr[8 * s_ + 7])};
                fr_[1][cb][s_] = (u32x4){cvt_pk_bf16(ti[8 * s_], ti[8 * s_ + 1]), cvt_pk_bf16(ti[8 * s_ + 2], ti[8 * s_ + 3]), cvt_pk_bf16(ti[8 * s_ + 4], ti[8 * s_ + 5]), cvt_pk_bf16(ti[8 * s_ + 6], ti[8 * s_ + 7])}; } }
#pragma unroll
        for (int ri = 0; ri < 2; ++ri)
#pragma unroll
            for (int s_ = 0; s_ < 2; ++s_) { const int f = (ri * 2 + rb) * 2 + s_;
#pragma unroll
                for (int kb = 0; kb < 2; ++kb) { const bf16x8 am = *(const LAS bf16x8*)(tM2 + (32 * kb + r32) * ROWB + f * 32 + hi * 16);
#pragma unroll
                    for (int cb = 0; cb < 2; ++cb) out[kb][cb] = __builtin_amdgcn_mfma_f32_32x32x16_bf16(am, __builtin_bit_cast(bf16x8, fr_[ri][cb][s_]), out[kb][cb], 0, 0, 0); } }
    }
    LAS bf16_t* stg = (LAS bf16_t*)(lds + L_STG);
#pragma unroll
    for (int kb = 0; kb < 2; ++kb)
#pragma unroll
        for (int cb = 0; cb < 2; ++cb)
#pragma unroll
            for (int r = 0; r < 16; ++r) { const int k2 = 32 * kb + crow(r, hi), k1 = 32 * cb + r32; stg[(k1 + 64 * k2) * 8 + wid] = (bf16_t)f2bf(out[kb][cb][r]); }
    __syncthreads();
    bf16_t* ob = AO + (size_t)b * S * D + 512 + chg * 8;
    for (int n = tid; n < S; n += NWAVES * 64) *(u32x4*)(ob + (size_t)n * D) = *(const LAS u32x4*)(lds + L_STG + n * 16);
    __syncthreads();
}
}

struct EpiBf16 {
    static constexpr bool PERM = true, AFTER_DRAIN = false;
    bf16_t* O; int ldc;
    __device__ __forceinline__ void operator()(const f32x4 (&acc)[2][2][4][2], const Unit& u, int wr, int wc, int fr, int fq) const {
        bf16_t* base = O + (size_t)u.i2 + (size_t)(u.i0 * 256 + wr * 64 + fr) * ldc + u.i1 * 256 + wc * 32 + 8 * fq;
#pragma unroll
        for (int ai = 0; ai < 2; ++ai)
#pragma unroll
            for (int m = 0; m < 4; ++m)
#pragma unroll
                for (int bj = 0; bj < 2; ++bj) { const f32x4 v0 = acc[ai][bj][m][0], v1 = acc[ai][bj][m][1];
                    u32x4 w; w.x = cvt_pk_bf16(v0[0], v0[1]); w.y = cvt_pk_bf16(v0[2], v0[3]); w.z = cvt_pk_bf16(v1[0], v1[1]); w.w = cvt_pk_bf16(v1[2], v1[3]);
                    *(u32x4*)(base + (size_t)(ai * HALF + m * 16) * ldc + bj * HALF) = w; }
    }
};
struct SchedFc { const char* Dc; const char* ZTc; int vcu;
    __device__ __forceinline__ bool next(int i, Unit& u) const { if (i > 0 || (vcu & 7) != 4 || (vcu >> 3) >= 8) return false; const int e = vcu >> 3, b = e >> 1, pn = e & 1;
        u.a = Dc; u.b = ZTc + ((size_t)b * 512 + pn * 256) * 512 * 2; u.i0 = 0; u.i1 = pn; u.i2 = (MLAT + b * 256) * D + 512; u.i3 = 0; return true; } };
struct SchedMN { const char* A; const char* B; int K, nM, nN, G, c;
    __device__ __forceinline__ bool next(int i, Unit& u) const {
        const int nwg = nM * nN; const long L = (long)i * G + c; if (L >= nwg) return false;
        int wgid = (int)L; { const int q = nwg / 8, r = nwg % 8, xcd = wgid % 8, off = wgid / 8; wgid = (xcd < r ? xcd * (q + 1) : r * (q + 1) + (xcd - r) * q) + off; }
        const int nig = 8 * nN, gid = wgid / nig, fm = gid * 8, gsz = (nM - fm) < 8 ? (nM - fm) : 8;
        const int pm = fm + ((wgid % nig) % gsz), pn = (wgid % nig) / gsz;
        u.a = A + (size_t)pm * 256 * K * 2; u.b = B + (size_t)pn * 256 * K * 2; u.i0 = pm; u.i1 = pn; u.i2 = 0; u.i3 = 0; return true; } };

struct EpiF32 {
    static constexpr bool PERM = false, AFTER_DRAIN = false;
    float* C; int ldc;
    __device__ __forceinline__ void operator()(const f32x4 (&acc)[2][2][4][2], const Unit& u, int wr, int wc, int fr, int fq) const {
        const int row0 = u.i0 * BM + wr * 64 + fr, col0 = u.i1 * BM + wc * 32 + 4 * fq;
#pragma unroll
        for (int ai = 0; ai < 2; ++ai)
#pragma unroll
            for (int m = 0; m < 4; ++m) { float* rowp = C + (size_t)(row0 + ai * HALF + m * 16) * ldc + col0;
#pragma unroll
                for (int bj = 0; bj < 2; ++bj)
#pragma unroll
                    for (int n = 0; n < 2; ++n) *(f32x4*)(rowp + bj * HALF + n * 16) = acc[ai][bj][m][n]; }
    }
};
struct EpiSwiGLU {
    static constexpr bool PERM = true, AFTER_DRAIN = false;
    bf16_t* Hd;
    __device__ __forceinline__ void operator()(const f32x4 (&acc)[2][2][4][2], const Unit& u, int wr, int wc, int fr, int fq) const {
        bf16_t* base = Hd + (size_t)(u.i0 * BM + wr * 64 + fr) * FF + u.i1 * HALF + wc * 32 + 8 * fq;
#pragma unroll
        for (int ai = 0; ai < 2; ++ai)
#pragma unroll
            for (int m = 0; m < 4; ++m) { float o[8];
#pragma unroll
                for (int n = 0; n < 2; ++n)
#pragma unroll
                    for (int j = 0; j < 4; ++j) { const float g = acc[ai][0][m][n][j], up = acc[ai][1][m][n][j];
                        const float sg = __builtin_amdgcn_rcpf(1.0f + __builtin_amdgcn_exp2f(-1.4426950408889634f * g)); o[4 * n + j] = g * sg * up; }
                u32x4 w; w.x = pk2(o[0], o[1]); w.y = pk2(o[2], o[3]); w.z = pk2(o[4], o[5]); w.w = pk2(o[6], o[7]);
                *(u32x4*)(base + (size_t)(ai * HALF + m * 16) * FF) = w; }
    }
};

__device__ __forceinline__ void post_row(const float* yrow, const float* xirow, float* xorow, const float* gain, const float* gate,
                                         bool do_xn, const float* gain2, const float* sh, const float* sc, bf16_t* xnrow, int lane) {
    f32x4 y[4], x[4]; float ss = 0.f;
#pragma unroll
    for (int j = 0; j < 4; ++j) { y[j] = *(const f32x4*)(yrow + lane * 4 + 256 * j); x[j] = *(const f32x4*)(xirow + lane * 4 + 256 * j);
        ss += (y[j][0] * y[j][0] + y[j][1] * y[j][1]) + (y[j][2] * y[j][2] + y[j][3] * y[j][3]); }
    const float rs = rsqrtf(wave_sum(ss) * (1.0f / D) + RMS_EPS);
    float s2 = 0.f;
#pragma unroll
    for (int j = 0; j < 4; ++j) { const int idx = lane * 4 + 256 * j; const f32x4 g = *(const f32x4*)(gain + idx), a = *(const f32x4*)(gate + idx);
        x[j] = x[j] + a * (y[j] * rs * g); *(f32x4*)(xorow + idx) = x[j];
        s2 += (x[j][0] * x[j][0] + x[j][1] * x[j][1]) + (x[j][2] * x[j][2] + x[j][3] * x[j][3]); }
    if (do_xn) { const float r2 = rsqrtf(wave_sum(s2) * (1.0f / D) + RMS_EPS);
#pragma unroll
        for (int j = 0; j < 4; ++j) { const int idx = lane * 4 + 256 * j; const f32x4 g = *(const f32x4*)(gain2 + idx), a = *(const f32x4*)(sc + idx), b = *(const f32x4*)(sh + idx);
            const f32x4 o = x[j] * r2 * g * (1.0f + a) + b; u32x2 w; w.x = pk2(o[0], o[1]); w.y = pk2(o[2], o[3]); *(u32x2*)(xnrow + idx) = w; } }
}
#define XB_TMO      128
#define XB_XCNT(j)  (256  + 64 * (j))
#define XB_XSUB(j)  (1280 + 64 * (j))
#define XB_XGEN(j)  (2304 + 64 * (j))
#define XB_TOP      3328
#define XB_TOPGEN   3392
#define XCD_BAR_WORDS 3456
#define XB_SPIN_CAP (1u << 18)
__device__ __forceinline__ unsigned xb_ld(unsigned* p)              { return __hip_atomic_load(p, __ATOMIC_RELAXED, __HIP_MEMORY_SCOPE_AGENT); }
__device__ __forceinline__ unsigned xb_add(unsigned* p, unsigned v) { return __hip_atomic_fetch_add(p, v, __ATOMIC_RELAXED, __HIP_MEMORY_SCOPE_AGENT); }
__device__ __forceinline__ unsigned xb_xcc_id() { return (unsigned)__builtin_amdgcn_s_getreg((3 << 11) | 20) & 0xFu; }
#define XB_SPIN(cond, bar) do { unsigned _sp = 0; while (cond) { __builtin_amdgcn_s_sleep(1); \
    if ((++_sp & 255u) == 0u) { if (xb_ld(&(bar)[XB_TMO])) break; if (_sp > XB_SPIN_CAP) { atomicAdd(&(bar)[XB_TMO], 1u); break; } } } } while (0)
struct XcdBarrier { unsigned* bar; unsigned x; volatile LAS unsigned* st; };
__device__ __forceinline__ XcdBarrier xcd_barrier_post(unsigned* bar, volatile LAS unsigned* st) {
    XcdBarrier b; b.bar = bar; b.x = xb_xcc_id(); b.st = st;
    if (threadIdx.x == 0) (void)xb_add(&bar[XB_XCNT(b.x)], 1u);
    return b;
}
__device__ __forceinline__ void xcd_barrier_complete(unsigned* bar, unsigned x, unsigned& nloc, unsigned& nx) {
    const unsigned G = gridDim.x * gridDim.y * gridDim.z;
    unsigned sum, cnt, mine, sp = 0u;
    for (;;) {
        sum = 0u; cnt = 0u; mine = 0u;
#pragma unroll
        for (unsigned j = 0; j < 16; ++j) { const unsigned c = xb_ld(&bar[XB_XCNT(j)]); sum += c; cnt += (c > 0u) ? 1u : 0u; mine = (j == x) ? c : mine; }
        if (sum == G) break;
        __builtin_amdgcn_s_sleep(1);
        if ((++sp & 255u) == 0u) { if (xb_ld(&bar[XB_TMO])) break; if (sp > XB_SPIN_CAP) { atomicAdd(&bar[XB_TMO], 1u); break; } }
    }
    nloc = mine > 0u ? mine : 1u; nx = cnt > 0u ? cnt : 1u;
}
__device__ __forceinline__ void xcd_barrier(const XcdBarrier& b) {
    asm volatile("s_waitcnt vmcnt(0)" ::: "memory");
    __syncthreads();
    if (threadIdx.x == 0) {
        unsigned* bar = b.bar;
        __builtin_amdgcn_s_waitcnt(0);
        unsigned nloc = b.st[0], nx = b.st[1];
        if (nloc == 0u) { xcd_barrier_complete(bar, b.x, nloc, nx); b.st[0] = nloc; b.st[1] = nx; }
        const unsigned old = xb_add(&bar[XB_XSUB(b.x)], 1u);
        const unsigned gen = old / nloc;
        if (old + 1u == (gen + 1u) * nloc) {
            __builtin_amdgcn_fence(__ATOMIC_RELEASE, "agent");
            asm volatile("s_waitcnt vmcnt(0)" ::: "memory");
            const unsigned og = xb_add(&bar[XB_TOP], 1u);
            const unsigned tg = og / nx;
            if (og + 1u == (tg + 1u) * nx) xb_add(&bar[XB_TOPGEN], 1u);
            else XB_SPIN(xb_ld(&bar[XB_TOPGEN]) == tg, bar);
            __builtin_amdgcn_fence(__ATOMIC_ACQUIRE, "agent");
            xb_add(&bar[XB_XGEN(b.x)], 1u);
            asm volatile("s_waitcnt vmcnt(0)" ::: "memory");
        } else {
            XB_SPIN(xb_ld(&bar[XB_XGEN(b.x)]) == gen, bar);
            __builtin_amdgcn_fence(__ATOMIC_ACQUIRE, "agent");
            asm volatile("s_waitcnt vmcnt(0)" ::: "memory");
        }
    }
    __syncthreads();
}

constexpr int RING_BYTES = 131072, PRO_TB_OFF = RING_BYTES, LDSCTL_OFF = PRO_TB_OFF + 8 * 256, MISC_OFF = LDSCTL_OFF + 320, LDS_BYTES = 147456;
constexpr size_t TAB_FFT = 16384, TAB_DC = 131072, TAB_FM = 393216;
constexpr int CW_BAR = 4096;
constexpr int N_PHASES = 16;
enum { SUB_INPROJ = 0, SUB_MIX = 1, SUB_OUT = 2, SUB_POST1 = 3, SUB_GATEUP = 4, SUB_DOWN = 5, SUB_POST2 = 6 };

struct Ctx {
    Frame F; unsigned char* ws; const float* const* in; float* out;
    const float *x_in, *c_in, *ctx_in, *c_ctx, *w_ada, *b_ada, *npm, *npo, *npf, *npof, *w_in, *w_out, *w_four, *w_gate, *w_up, *w_down, *sink;
    float *mod, *rope, *Y, *XC; unsigned char* tabs;
    bf16_t *XN, *Qb, *Kb, *Vb, *ZT, *ZTc, *AO, *HID;
    int gw, NGW, p0sel;
};
template <int ph> __device__ __forceinline__ void run_phase(const Ctx& c) {
    constexpr int l = ph < 2 ? 0 : (ph - 2) / 7; constexpr int sub = ph < 2 ? -1 : (ph - 2) % 7;
    const Frame& F = c.F; unsigned char* ws = c.ws; float* out = c.out;
    const float *x_in = c.x_in, *c_in = c.c_in, *ctx_in = c.ctx_in, *c_ctx = c.c_ctx, *w_ada = c.w_ada, *b_ada = c.b_ada, *npm = c.npm, *npo = c.npo, *npf = c.npf, *npof = c.npof;
    const float *w_in = c.w_in, *w_out = c.w_out, *w_four = c.w_four, *w_gate = c.w_gate, *w_up = c.w_up, *w_down = c.w_down;
    float *mod = c.mod, *rope = c.rope, *Y = c.Y, *XC = c.XC; unsigned char* tabs = c.tabs;
    bf16_t *XN = c.XN, *Qb = c.Qb, *Kb = c.Kb, *Vb = c.Vb, *ZT = c.ZT, *ZTc = c.ZTc, *AO = c.AO, *HID = c.HID;
    const int gw = c.gw, NGW = c.NGW;
        const char* wl = (const char*)(ws + WS_W + (size_t)l * W_LSTRIDE);
        const int nMt = l == 0 ? 68 : 64;

        if constexpr (ph == 0) {
            LAS float* scr = (LAS float*)(F.lds + F.wave * 16384); LAS float* tb = (LAS float*)(F.lds + PRO_TB_OFF + F.wave * 256);
            constexpr int I_TR = 5120, I_FOLD = 16, I_ADA = 768, I_FT = 386, I_DC = 256;
            constexpr int NITEMS = 2 * (I_TR + I_FOLD + I_ADA) + 16 + I_FT + I_DC;
            for (int it = gw; it < NITEMS; it += NGW) {
                int r = it;
                { const int cls = r < 2 * I_TR ? 1 : (r < 2 * (I_TR + I_FOLD) ? 2 : (r < 2 * (I_TR + I_FOLD + I_ADA) ? 4 : 8)); if (c.p0sel != 0 && (c.p0sel & cls) == 0) continue; }
                if (r < 2 * I_TR) { const int ll = r / I_TR; r -= ll * I_TR; unsigned char* wll = ws + WS_W + (size_t)ll * W_LSTRIDE;
                    if (r < 384) { const int kb = r / 24, nb = r % 24; p0_tr_item(w_in + (size_t)ll * D * INW, INW, 64 * kb, 32 * nb, (bf16_t*)(wll + W_QKV), D, 32 * nb, scr, F.lane); continue; } r -= 384;
                    if (r < 512) { const int kb = r / 32, nb = r % 32; p0_tr_item(w_out + (size_t)ll * D * D, D, 64 * kb, 32 * nb, (bf16_t*)(wll + W_O), D, 32 * nb, scr, F.lane); continue; } r -= 512;
                    if (r < 1408) { const int kb = r / 88, nb = r % 88, n0 = 32 * nb; p0_tr_item(w_gate + (size_t)ll * D * FF, FF, 64 * kb, n0, (bf16_t*)(wll + W_GU), D, 256 * (n0 >> 7) + (n0 & 127), scr, F.lane); continue; } r -= 1408;
                    if (r < 1408) { const int kb = r / 88, nb = r % 88, n0 = 32 * nb; p0_tr_item(w_up + (size_t)ll * D * FF, FF, 64 * kb, n0, (bf16_t*)(wll + W_GU), D, 256 * (n0 >> 7) + 128 + (n0 & 127), scr, F.lane); continue; } r -= 1408;
                    { const int kb = r / 32, nb = r % 32; p0_tr_item(w_down + (size_t)ll * FF * D, D, 64 * kb, 32 * nb, (bf16_t*)(wll + W_D), FF, 32 * nb, scr, F.lane); }
                    continue; }
                r -= 2 * I_TR;
                if (r < 2 * I_FOLD) { const int ll = r / I_FOLD; r -= ll * I_FOLD; const int type = r >> 3, g = r & 7;
                    p0_foldM_item(w_four + ((size_t)ll * 8 + g) * 4096, (float*)(tabs + TAB_FM) + (size_t)((ll * 2 + type) * 8 + g) * 4096, type, tb, F.lane); continue; }
                r -= 2 * I_FOLD;
                if (r < 2 * I_ADA) { const int ll = r / I_ADA; r -= ll * I_ADA; p0_adaln_item(c_in, c_ctx, w_ada, b_ada, mod, ll, r >> 5, r & 31, scr, F.lane); continue; }
                r -= 2 * I_ADA;
                if (r >= 16) { r -= 16;
                    if (r < I_FT) { fft::gen_table_entry(tabs + TAB_FFT, r * 64 + F.lane); continue; }
                    r -= I_FT;
                    bf16_t* dc = (bf16_t*)(tabs + TAB_DC) + (size_t)r * 512;
                    for (int i = 0; i < 8; ++i) { const int col = F.lane + 64 * i, type = col >> 8, n = col & 255; float s_, c_; sincospif((float)((n * r) & 255) / 128.0f, &s_, &c_); dc[col] = (bf16_t)f2bf(type == 0 ? 4.0f * c_ : -4.0f * s_); }
                    continue; }
                { const int e = r * 64 + F.lane; const int pos = e >> 4, f = e & 15; const float fr_ = powf(10000.0f, -(float)f / 16.0f); const float a = (float)pos * fr_; rope[2 * e] = cosf(a); rope[2 * e + 1] = sinf(a); }
            }
        }
        else if constexpr (ph == 1) {
            { LAS float* scr = (LAS float*)(F.lds + F.wave * 16384);
              for (int it = gw; it < 2048; it += NGW) { const int ll = it >> 10, type = (it >> 9) & 1, g = (it >> 6) & 7, kb = it & 63;
                  p0_fold_item(w_in + (size_t)ll * D * INW, (const float*)(tabs + TAB_FM) + (size_t)((ll * 2 + type) * 8 + g) * 4096, (bf16_t*)(ws + WS_W + (size_t)ll * W_LSTRIDE + W_Z), type, g, 16 * kb, scr, F.lane); } }
            for (int m = gw; m < MT; m += NGW) {
                const float* src = m < MLAT ? x_in + (size_t)m * D : ctx_in + (size_t)(m - MLAT) * D;
                const int r = m < MLAT ? (m >> 12) : 4; const float* ml = mod + (size_t)r * 6144;
                normmod_row(src, npm, ml, ml + 1024, XN + (size_t)m * D, F.lane);
            }
        }
        else if constexpr (sub == SUB_INPROJ) {
            { SchedZ Sz{wl + W_Z, (const char*)XN, F.vcu}; EpiZ Ez{ZT}; gemm_phase<EpiZ, SchedZ, 1, false>(F.lds, D, Sz, Ez); }
            { SchedQKV Sq{(const char*)XN, wl + W_QKV, F.vcu, l == 0 ? 1 : 0}; EpiQKV Eq{Qb, Kb, Vb, rope}; gemm_phase<EpiQKV, SchedQKV, 0, false>(F.lds, D, Sq, Eq); }
            if (l == 0) { SchedZc Sc{wl + W_Z, (const char*)XN, F.vcu}; EpiZc Ec{ZTc}; gemm_phase<EpiZc, SchedZc, 0, false>(F.lds, D, Sc, Ec); }
        }
        else if constexpr (sub == SUB_MIX) {
            const float* sinkl = c.sink + l * 8;
            for (int i = 0; i < 2; ++i) { const int uid = F.vcu * 2 + i; const int b = uid >> 7, kvh = (uid >> 6) & 1, qb = uid & 63;
                att::attn_unit(F.lds, Qb, Kb, Vb, AO, sinkl, b * S + 64 * qb, kvh, MLAT + b * CL, b * S, qb); }
            if (l == 0 && (F.vcu & 7) == 0) { const int e = F.vcu >> 3; const int b = e >> 3, kvh = (e >> 2) & 1, qb = e & 3;
                att::attn_unit(F.lds, Qb, Kb, Vb, AO, sinkl, MLAT + b * CL + 64 * qb, kvh, MLAT + b * CL, -1, qb); }
            fft::fft_load_tables(F.lds, tabs + TAB_FFT); __syncthreads();
            fft::fft_unit(F.lds, ZT, AO, F.vcu >> 6, F.vcu & 63);
            if (l == 0) { SchedFc Sf{(const char*)(tabs + TAB_DC), (const char*)ZTc, F.vcu}; EpiBf16 Ef{AO, D}; gemm_phase<EpiBf16, SchedFc, 0, false>(F.lds, 512, Sf, Ef); }
        }
        else if constexpr (sub == SUB_OUT) {
            SchedMN Sm{(const char*)AO, wl + W_O, D, nMt, 4, F.G, (int)blockIdx.x}; EpiF32 Ey{Y, D};
            gemm_phase<EpiF32, SchedMN, 0, false>(F.lds, D, Sm, Ey);
        }
        else if constexpr (sub == SUB_POST1 || sub == SUB_POST2) {
            const bool p1 = sub == SUB_POST1; const int nrows = nMt * 256;
            for (int m = gw; m < nrows; m += NGW) {
                const bool lat = m < MLAT; const int r = lat ? (m >> 12) : 4; const float* ml = mod + (size_t)(l * 5 + r) * 6144;
                float* xo = lat ? out + (size_t)m * D : XC + (size_t)(m - MLAT) * D;
                const float* xi = (p1 && l == 0) ? (lat ? x_in + (size_t)m * D : ctx_in + (size_t)(m - MLAT) * D) : xo;
                if (p1) post_row(Y + (size_t)m * D, xi, xo, npo + l * D, ml + 2 * 1024, true, npf + l * D, ml + 3 * 1024, ml + 4 * 1024, XN + (size_t)m * D, F.lane);
                else { const float* ml1 = mod + (size_t)(5 + r) * 6144;
                    post_row(Y + (size_t)m * D, xi, xo, npof + l * D, ml + 5 * 1024, l == 0, npm + D, ml1, ml1 + 1024, XN + (size_t)m * D, F.lane); }
            }
        }
        else if constexpr (sub == SUB_GATEUP) {
            SchedMN Sm{(const char*)XN, wl + W_GU, D, nMt, NGU / 256, F.G, (int)blockIdx.x}; EpiSwiGLU Eg{HID};
            gemm_phase<EpiSwiGLU, SchedMN, 0, true>(F.lds, D, Sm, Eg);
        }
        else if constexpr (sub == SUB_DOWN) {
            SchedMN Sm{(const char*)HID, wl + W_D, FF, nMt, 4, F.G, (int)blockIdx.x}; EpiF32 Ey{Y, D};
            gemm_phase<EpiF32, SchedMN, 0, false>(F.lds, FF, Sm, Ey);
        }
}

__global__ void __launch_bounds__(NWAVES * 64, 2) mk_fwd(Args args) {
    extern __shared__ __attribute__((aligned(16))) unsigned char lds_raw[];
    Frame F; F.lds = (LAS unsigned char*)lds_raw; F.tid = threadIdx.x; F.lane = F.tid & 63; F.wave = __builtin_amdgcn_readfirstlane(F.tid >> 6);
    F.G = gridDim.x; { const int bx = blockIdx.x; F.vcu = (F.G % 8 == 0) ? (bx % 8) * (F.G / 8) + bx / 8 : bx; }
    unsigned char* ws = args.ws;
    const float* x_in = args.in[0]; const float* c_in = args.in[1]; const float* ctx_in = args.in[2]; const float* c_ctx = args.in[3];
    const float* w_ada = args.in[4]; const float* b_ada = args.in[5]; const float* npm = args.in[6]; const float* npo = args.in[7]; const float* npf = args.in[8]; const float* npof = args.in[9];
    const float* w_in = args.in[10]; const float* w_out = args.in[11]; const float* w_four = args.in[12];
    const float* w_gate = args.in[14]; const float* w_up = args.in[15]; const float* w_down = args.in[16];
    float* out = args.out;
    float* mod = (float*)(ws + WS_CTL + CTL_MOD_OFF);
    unsigned char* tabs = ws + WS_TAB; float* rope = (float*)(tabs + TAB_ROPE);
    bf16_t* XN = (bf16_t*)(ws + WS_XN); bf16_t* Qb = (bf16_t*)(ws + WS_Q); bf16_t* Kb = (bf16_t*)(ws + WS_K); bf16_t* Vb = (bf16_t*)(ws + WS_V);
    bf16_t* ZT = (bf16_t*)(ws + WS_ZT); bf16_t* ZTc = (bf16_t*)(ws + WS_ZTC); bf16_t* AO = (bf16_t*)(ws + WS_AO); bf16_t* HID = (bf16_t*)(ws + WS_HID);
    float* Y = (float*)(ws + WS_Y); float* XC = (float*)(ws + WS_XC);
    const int lo = args.ph_lo, hi = args.ph_hi;
    const int gw = F.vcu * NWAVES + F.wave, NGW = F.G * NWAVES;
    Ctx c; c.F = F; c.ws = ws; c.in = nullptr; c.out = out; c.x_in = x_in; c.c_in = c_in; c.ctx_in = ctx_in; c.c_ctx = c_ctx; c.w_ada = w_ada; c.b_ada = b_ada; c.npm = npm; c.npo = npo; c.npf = npf; c.npof = npof;
    c.w_in = w_in; c.w_out = w_out; c.w_four = w_four; c.w_gate = w_gate; c.w_up = w_up; c.w_down = w_down; c.sink = args.in[13]; c.mod = mod; c.rope = rope; c.Y = Y; c.XC = XC; c.tabs = tabs;
    c.XN = XN; c.Qb = Qb; c.Kb = Kb; c.Vb = Vb; c.ZT = ZT; c.ZTc = ZTc; c.AO = AO; c.HID = HID; c.gw = gw; c.NGW = NGW; c.p0sel = args.pad;
    for (int u = F.tid; u < (LDS_BYTES - LDSCTL_OFF) / 4; u += NWAVES * 64) ((LAS unsigned*)(F.lds + LDSCTL_OFF))[u] = 0u;
    __syncthreads();
    XcdBarrier bar; bar.bar = (unsigned*)(ws + WS_CTL) + CW_BAR; bar.x = 0; bar.st = nullptr;
    if (hi - lo > 1) bar = xcd_barrier_post((unsigned*)(ws + WS_CTL) + CW_BAR, (volatile LAS unsigned*)(F.lds + MISC_OFF) + 8);

#define MK_PHASE(PH) if (lo <= (PH) && (PH) < hi) { run_phase<PH>(c); if ((PH) + 1 < hi) xcd_barrier(bar); }
    MK_PHASE(0)
    MK_PHASE(1)
    MK_PHASE(2)
    MK_PHASE(3)
    MK_PHASE(4)
    MK_PHASE(5)
    MK_PHASE(6)
    MK_PHASE(7)
    MK_PHASE(8)
    MK_PHASE(9)
    MK_PHASE(10)
    MK_PHASE(11)
    MK_PHASE(12)
    MK_PHASE(13)
    MK_PHASE(14)
    MK_PHASE(15)
#undef MK_PHASE
}
}

extern "C" void kernel_launch(void* const* d_in, const int* in_sizes, int n_in, void* d_out, int out_size, void* d_ws, size_t ws_size, hipStream_t stream) {
    static int grid = 0;
    if (grid == 0) {
        int dev = 0, cus = 0, per_cu = 0;
        if (hipGetDevice(&dev) != hipSuccess || hipDeviceGetAttribute(&cus, hipDeviceAttributeMultiprocessorCount, dev) != hipSuccess) { grid = -1; }
        else if (hipFuncSetAttribute((const void*)mk::mk_fwd, hipFuncAttributeMaxDynamicSharedMemorySize, mk::LDS_BYTES) != hipSuccess) { grid = -1; }
        else { if (hipOccupancyMaxActiveBlocksPerMultiprocessor(&per_cu, (const void*)mk::mk_fwd, mk::NWAVES * 64, mk::LDS_BYTES) != hipSuccess) per_cu = 0;
               (void)hipGetLastError();
               grid = (per_cu >= 1 && cus >= 256) ? 256 : -1; }
        if (grid < 0) fprintf(stderr, "kernel_launch: needs 256 CUs with one resident 512-thread workgroup each (cus %d, per_cu %d); nothing launched\n", cus, per_cu);
    }
    if (grid < 0) return;
    if (hipMemsetAsync((char*)d_ws + mk::WS_CTL, 0, mk::CTL_ZERO_BYTES, stream) != hipSuccess) return;
    mk::Args a{};
    for (int i = 0; i < 17; ++i) a.in[i] = (const float*)d_in[i];
    a.out = (float*)d_out; a.ws = (unsigned char*)d_ws; a.xsrc = nullptr; a.xcsrc = nullptr; a.layer = 0; a.pad = 0;
#ifndef MK_N_LAUNCHES
#define MK_N_LAUNCHES 1
#endif
#if MK_N_LAUNCHES == 1
    a.ph_lo = 0; a.ph_hi = mk::N_PHASES;
    hipLaunchKernelGGL(mk::mk_fwd, dim3(grid), dim3(mk::NWAVES * 64), mk::LDS_BYTES, stream, a);
#else
#ifndef MK_DUPMASK
#define MK_DUPMASK 0
#endif
#ifndef MK_P0PROBE
#define MK_P0PROBE 0
#endif
    for (int ph = 0; ph < mk::N_PHASES; ++ph) { const int reps = ((MK_DUPMASK >> ph) & 1) ? 3 : 1;
        if (ph == 0 && MK_P0PROBE != 0) {
            a.ph_lo = 0; a.ph_hi = 1; a.pad = 0; hipLaunchKernelGGL(mk::mk_fwd, dim3(grid), dim3(mk::NWAVES * 64), mk::LDS_BYTES, stream, a);
            for (int r = 0; r < 2; ++r) { if (MK_P0PROBE == 4) { (void)hipMemsetAsync((char*)d_ws + mk::WS_CTL, 0, mk::CTL_ZERO_BYTES, stream); } a.pad = MK_P0PROBE; hipLaunchKernelGGL(mk::mk_fwd, dim3(grid), dim3(mk::NWAVES * 64), mk::LDS_BYTES, stream, a); }
            a.pad = 0; continue; }
        for (int r = 0; r < reps; ++r) { if (ph == 0 && r > 0) (void)hipMemsetAsync((char*)d_ws + mk::WS_CTL, 0, mk::CTL_ZERO_BYTES, stream); a.ph_lo = ph; a.ph_hi = ph + 1; hipLaunchKernelGGL(mk::mk_fwd, dim3(grid), dim3(mk::NWAVES * 64), mk::LDS_BYTES, stream, a); } }
#endif
}
```

```cpp
#include <hip/hip_runtime.h>
#include <cstdint>
#include <cstdio>
#define MK_N_LAUNCHES 1
#define MK_DUPMASK 0
#define MK_P0PROBE 0
namespace mk {
#define LAS __attribute__((address_space(3)))
#define GAS __attribute__((address_space(1)))
typedef unsigned short bf16_t;
typedef short bf16x8 __attribute__((ext_vector_type(8)));
typedef float f32x4 __attribute__((ext_vector_type(4)));
typedef float f32x2 __attribute__((ext_vector_type(2)));
typedef float f32x16 __attribute__((ext_vector_type(16)));
typedef unsigned u32x4 __attribute__((ext_vector_type(4)));
typedef unsigned u32x2 __attribute__((ext_vector_type(2)));

constexpr int D = 1024, NB = 4, S = 4096, CL = 256, MLAT = NB * S, MCTX = NB * CL, MT = MLAT + MCTX;
constexpr int NQKV = 768, FF = 2816, NGU = 2 * FF, INW = 1280;
constexpr float C2 = 0.125f * 1.4426950408889634f;
constexpr float RMS_EPS = 1e-6f;
constexpr int NWAVES = 8;
constexpr int BM = 256, BK = 64, HALF = 128, HTB = HALF * BK * 2, STAGE_BYTES = 8 * HTB;

__device__ __forceinline__ int lds_byte(int r, int c) { const int st = (r >> 4) * 2 + (c >> 5), rr = r & 15, cc = c & 31, ob = rr * 64 + cc * 2; return st * 1024 + (ob ^ (((ob >> 9) & 1) << 5)); }
__device__ __forceinline__ void stage_rc(int b, int& R, int& C) { const int st = b / 1024, sb = b % 1024, swz = sb ^ (((sb >> 9) & 1) << 5); R = (st >> 1) * 16 + swz / 64; C = (st & 1) * 32 + (swz % 64) / 2; }
__device__ __forceinline__ int perm32(int rho) { const int n = rho >> 4, i = rho & 15; return 8 * (i >> 2) + 4 * n + (i & 3); }
typedef __bf16 bf16x2_t __attribute__((ext_vector_type(2)));
__device__ __forceinline__ unsigned cvt_pk_bf16(float lo, float hi) { unsigned r; asm volatile("v_cvt_pk_bf16_f32 %0, %1, %2" : "=v"(r) : "v"(lo), "v"(hi)); return r; }
__device__ __forceinline__ unsigned cvtpk_s(float lo, float hi) { const float __attribute__((ext_vector_type(2))) v = {lo, hi}; const bf16x2_t b = __builtin_convertvector(v, bf16x2_t); return __builtin_bit_cast(unsigned, b); }
__device__ __forceinline__ unsigned f2bf(float f) { unsigned u = __builtin_bit_cast(unsigned, f); return (u + 0x7fffu + ((u >> 16) & 1u)) >> 16; }
__device__ __forceinline__ unsigned pk2(float lo, float hi) { return f2bf(lo) | (f2bf(hi) << 16); }
__device__ __forceinline__ float bf2f(bf16_t v) { return __builtin_bit_cast(float, (unsigned)v << 16); }
__device__ __forceinline__ float wave_sum(float v) {
#pragma unroll
    for (int o = 1; o < 64; o <<= 1) v += __shfl_xor(v, o);
    return v;
}

struct Unit { const char* a; const char* b; int i0, i1, i2, i3; };

template <class Epi, class Sched, int BMAP, bool ALIGN_EPI>
__device__ __forceinline__ void gemm_phase(LAS unsigned char* lds, const int K, const Sched& S, const Epi& E) {
    const int tid = threadIdx.x, wid = __builtin_amdgcn_readfirstlane(tid >> 6), lane = tid & 63, wr = wid >> 2, wc = wid & 3, fr = lane & 15, fq = lane >> 4;
    const int nt = K / BK;
    unsigned voffA[2], voffB[2];
#pragma unroll
    for (int i = 0; i < 2; ++i) { int R, C; stage_rc(tid * 16 + i * 8192, R, C); const int Rb = Epi::PERM ? ((R & ~31) + perm32(R & 31)) : R;
        const int Rm = (BMAP == 1) ? (64 * (Rb & 63) + (Rb >> 6)) : Rb;
        voffA[i] = (unsigned)(R * K + C) * 2u; voffB[i] = (unsigned)(Rm * K + C) * 2u; }
    const size_t kstep = (size_t)(BK * 2);
    const size_t hstepA = (size_t)HALF * K * 2;
    const size_t hstepB = (BMAP == 1) ? (size_t)2 * K * 2 : (size_t)HALF * K * 2;
    const unsigned ldsw = (unsigned)wid * 1024u;
    const int aoff = lds_byte(wr * 64 + fr, fq * 8), boff = lds_byte(wc * 32 + fr, fq * 8);
#define PG8_SA(b, h) (((b) * 2 + (h)) * HTB)
#define PG8_SB(b, h) ((4 + (b) * 2 + (h)) * HTB)
#define PG8_STAGE(bufoff, gbase, voff) do { _Pragma("unroll") for (int _i = 0; _i < 2; ++_i) \
        __builtin_amdgcn_global_load_lds((const unsigned*)((const char*)(gbase) + (voff)[_i]), (LAS unsigned*)(lds + (bufoff) + ldsw + _i * 8192), 16, 0, 0); } while (0)
#define PG8_LDA(dst, b, h) do { _Pragma("unroll") for (int m = 0; m < 4; ++m) _Pragma("unroll") for (int k = 0; k < 2; ++k) dst[m][k] = *(const LAS bf16x8*)(lds + PG8_SA(b, h) + aoff + m * 2048 + k * 1024); } while (0)
#define PG8_LDB(dst, b, h) do { _Pragma("unroll") for (int n = 0; n < 2; ++n) _Pragma("unroll") for (int k = 0; k < 2; ++k) dst[n][k] = *(const LAS bf16x8*)(lds + PG8_SB(b, h) + boff + n * 2048 + k * 1024); } while (0)
#define PG8_MMA(ai, bj, At, Bt) do { __builtin_amdgcn_s_setprio(1); _Pragma("unroll") for (int m = 0; m < 4; ++m) _Pragma("unroll") for (int n = 0; n < 2; ++n) _Pragma("unroll") for (int k = 0; k < 2; ++k) \
        acc[ai][bj][m][n] = __builtin_amdgcn_mfma_f32_16x16x32_bf16(Bt[n][k], At[m][k], acc[ai][bj][m][n], 0, 0, 0); __builtin_amdgcn_s_setprio(0); } while (0)
#define PG8_WAIT_V(n) asm volatile("s_waitcnt vmcnt(" #n ")" ::: "memory")
#define PG8_WAIT_L(n) asm volatile("s_waitcnt lgkmcnt(" #n ")" ::: "memory")
#define PG8_BAR __builtin_amdgcn_s_barrier()
#define PG8_SCHED __builtin_amdgcn_sched_barrier(0)
    Unit cur, nxt; int ui = 0;
    if (!S.next(0, cur)) return;
    f32x4 acc[2][2][4][2];
#pragma unroll
    for (int a = 0; a < 2; ++a)
#pragma unroll
        for (int b = 0; b < 2; ++b)
#pragma unroll
            for (int m = 0; m < 4; ++m)
#pragma unroll
                for (int n = 0; n < 2; ++n) acc[a][b][m][n] = (f32x4){0.f, 0.f, 0.f, 0.f};
    bf16x8 At[4][2], B0[2][2], B1[2][2];
    const char* cA = cur.a; const char* cB = cur.b;
    PG8_STAGE(PG8_SB(0, 0), cB, voffB); PG8_STAGE(PG8_SB(0, 1), cB + hstepB, voffB); PG8_STAGE(PG8_SA(0, 0), cA, voffA); PG8_STAGE(PG8_SA(0, 1), cA + hstepA, voffA);
    if (wr == 1) PG8_BAR;
    PG8_WAIT_V(2); PG8_BAR;
    PG8_STAGE(PG8_SB(1, 0), cB + kstep, voffB); PG8_STAGE(PG8_SA(1, 0), cA + kstep, voffA); PG8_STAGE(PG8_SB(1, 1), cB + hstepB + kstep, voffB);
    PG8_WAIT_V(6); PG8_BAR;
    for (;;) {
        const bool has_next = S.next(ui + 1, nxt);
        const char* nA = has_next ? nxt.a : cA; const char* nB = has_next ? nxt.b : cB;
        for (int t = 0; t < nt; t += 2) {
            const bool last = (t == nt - 2);
            const char* a1 = cA + (size_t)(t + 1) * kstep;
            const char* a2 = last ? nA : cA + (size_t)(t + 2) * kstep; const char* b2 = last ? nB : cB + (size_t)(t + 2) * kstep;
            const char* a3 = a2 + kstep; const char* b3 = b2 + kstep;
            PG8_LDB(B0, 0, 0); PG8_LDB(B1, 0, 1); PG8_SCHED; PG8_LDA(At, 0, 0); PG8_STAGE(PG8_SA(1, 1), a1 + hstepA, voffA);
            PG8_WAIT_V(8); PG8_WAIT_L(0); PG8_BAR; PG8_MMA(0, 0, At, B0); PG8_MMA(0, 1, At, B1); PG8_BAR; PG8_SCHED;
            PG8_LDA(At, 0, 1); PG8_STAGE(PG8_SB(0, 0), b2, voffB); PG8_STAGE(PG8_SB(0, 1), b2 + hstepB, voffB); PG8_STAGE(PG8_SA(0, 0), a2, voffA);
            PG8_WAIT_V(8); PG8_WAIT_L(0); PG8_BAR; PG8_MMA(1, 0, At, B0); PG8_MMA(1, 1, At, B1); PG8_BAR; PG8_SCHED;
            PG8_LDB(B0, 1, 0); PG8_LDB(B1, 1, 1); PG8_SCHED; PG8_LDA(At, 1, 0); PG8_STAGE(PG8_SA(0, 1), a2 + hstepA, voffA);
            PG8_WAIT_V(8); PG8_WAIT_L(0); PG8_BAR; PG8_MMA(0, 0, At, B0); PG8_MMA(0, 1, At, B1); PG8_BAR; PG8_SCHED;
            PG8_LDA(At, 1, 1); PG8_STAGE(PG8_SB(1, 0), b3, voffB); PG8_STAGE(PG8_SB(1, 1), b3 + hstepB, voffB); PG8_STAGE(PG8_SA(1, 0), a3, voffA);
            PG8_WAIT_V(8); PG8_WAIT_L(0); PG8_BAR; PG8_MMA(1, 0, At, B0); PG8_MMA(1, 1, At, B1); PG8_BAR; PG8_SCHED;
        }
        if constexpr (ALIGN_EPI) { if (wr == 0) PG8_BAR; }
        if constexpr (!Epi::AFTER_DRAIN) { E(acc, cur, wr, wc, fr, fq); }
        if (!has_next) break;
#pragma unroll
        for (int a = 0; a < 2; ++a)
#pragma unroll
            for (int b = 0; b < 2; ++b)
#pragma unroll
                for (int m = 0; m < 4; ++m)
#pragma unroll
                    for (int n = 0; n < 2; ++n) acc[a][b][m][n] = (f32x4){0.f, 0.f, 0.f, 0.f};
        cur = nxt; cA = nA; cB = nB; ++ui;
        if constexpr (ALIGN_EPI) { if (wr == 1) PG8_BAR; }
    }
    PG8_WAIT_V(0);
    if constexpr (!ALIGN_EPI) { if (wr == 0) PG8_BAR; }
    PG8_BAR;
    if constexpr (Epi::AFTER_DRAIN) { E.fused(acc, cur, wr, wc, fr, fq, lds, wid, lane); }
#undef PG8_SA
#undef PG8_SB
#undef PG8_STAGE
#undef PG8_LDA
#undef PG8_LDB
#undef PG8_MMA
#undef PG8_WAIT_V
#undef PG8_WAIT_L
#undef PG8_BAR
#undef PG8_SCHED
}
constexpr size_t MiB = 1u << 20;
#ifndef MK_WS_MAP_HYBRID
#define MK_WS_MAP_HYBRID 0
#endif
constexpr size_t WS_CTL = 0, CTL_ZERO_BYTES = 1 * MiB;
constexpr size_t CTL_MOD_OFF = 512 * 1024;
constexpr size_t W_QKV = 0, W_Z = 1536 * 1024, W_O = W_Z + 2 * MiB, W_GU = W_O + 2 * MiB, W_D = W_GU + 11 * MiB, W_LAYER = 22 * MiB;
#if MK_WS_MAP_HYBRID
constexpr size_t WS_TAB = 6 * MiB;
constexpr size_t WS_ZT = 8 * MiB, WS_ZTC = 40 * MiB;
constexpr size_t WS_XN = 161 * MiB;
constexpr size_t WS_Q = 195 * MiB, WS_K = 212 * MiB, WS_V = WS_K + 4352 * 1024;
constexpr size_t WS_W = 229 * MiB;
constexpr size_t W_LSTRIDE = 4 * MiB;
constexpr size_t WS_AO = 76 * MiB;
#else
constexpr size_t WS_TAB = 1 * MiB;
constexpr size_t WS_W = 2 * MiB; constexpr size_t W_LSTRIDE = W_LAYER;
constexpr size_t WS_XN = 46 * MiB;
constexpr size_t WS_Q = 80 * MiB, WS_K = 97 * MiB, WS_V = WS_K + 4352 * 1024, WS_ZT = WS_V + 4352 * 1024, WS_ZTC = WS_ZT + 32 * MiB, WS_AO = WS_ZTC + 2 * MiB;
constexpr size_t WS_HID = 80 * MiB;
constexpr size_t WS_Y = 174 * MiB;
constexpr size_t WS_XC = 242 * MiB;
#endif
constexpr size_t TAB_ROPE = 0;

struct Args {
    const float* in[17]; float* out; unsigned char* ws;
    const float* xsrc; const float* xcsrc;
    int ph_lo, ph_hi, layer, pad;
};

struct Frame {
    LAS unsigned char* lds;
    int tid, lane, wave, vcu, G;
};

__device__ __forceinline__ void p0_tr_item(const float* W, int pitch, int k0, int n0src, bf16_t* WT, int K, int drow0, LAS float* scr, int lane) {
#pragma unroll 8
    for (int i = 0; i < 32; ++i) { const int kk = 2 * i + (lane >> 5); scr[kk * 33 + (lane & 31)] = W[(size_t)(k0 + kk) * pitch + n0src + (lane & 31)]; }
    asm volatile("s_waitcnt lgkmcnt(0)" ::: "memory");
    const int c = lane & 7;
#pragma unroll
    for (int j = 0; j < 4; ++j) { const int n = (lane >> 3) + 8 * j; const LAS float* s = scr + (8 * c) * 33 + n;
        u32x4 o; o.x = pk2(s[0 * 33], s[1 * 33]); o.y = pk2(s[2 * 33], s[3 * 33]); o.z = pk2(s[4 * 33], s[5 * 33]); o.w = pk2(s[6 * 33], s[7 * 33]);
        *(u32x4*)(WT + (size_t)(drow0 + n) * K + k0 + 8 * c) = o; }
    asm volatile("s_waitcnt lgkmcnt(0)" ::: "memory");
}

__device__ __forceinline__ void p0_foldM_item(const float* wf_lg, float* M, int type, int c0, int lane) {
    float wfr[64];
#pragma unroll
    for (int cp = 0; cp < 64; ++cp) wfr[cp] = wf_lg[cp * 64 + lane];
    for (int c = c0; c < c0 + 8; ++c) {
        float s, co; sincospif((float)((c * lane) & 63) / 32.0f, &s, &co); const float tv = type == 0 ? co : s;
        float a0 = 0.f, a1 = 0.f;
#pragma unroll
        for (int cp = 0; cp < 64; cp += 2) { a0 += __builtin_bit_cast(float, __builtin_amdgcn_readlane(__builtin_bit_cast(int, tv), cp)) * wfr[cp];
                                             a1 += __builtin_bit_cast(float, __builtin_amdgcn_readlane(__builtin_bit_cast(int, tv), cp + 1)) * wfr[cp + 1]; }
        M[c * 64 + lane] = (a0 + a1) * (1.0f / 512.0f); }
}
__device__ __forceinline__ void p0_fold_item(const float* w_in_l, const float* M, bf16_t* WZ, int type, int g, int k0, LAS float* scr, int lane) {
    float mr[64];
#pragma unroll
    for (int c = 0; c < 64; ++c) mr[c] = M[c * 64 + lane];
    { const float* wrow = w_in_l + (size_t)(k0 + (lane >> 2)) * INW + 768 + g * 64 + (lane & 3) * 16;
#pragma unroll
      for (int j = 0; j < 4; ++j) *(LAS f32x4*)(scr + (lane >> 2) * 64 + (lane & 3) * 16 + 4 * j) = *(const f32x4*)(wrow + 4 * j); }
    asm volatile("s_waitcnt lgkmcnt(0)" ::: "memory");
    bf16_t* orow = WZ + (size_t)(type * 512 + g * 64 + lane) * D + k0;
#pragma unroll 1
    for (int k = 0; k < 16; k += 2) { float a0 = 0.f, a1 = 0.f;
#pragma unroll
        for (int c4 = 0; c4 < 16; ++c4) { const f32x4 w0 = *(const LAS f32x4*)(scr + k * 64 + 4 * c4), w1 = *(const LAS f32x4*)(scr + (k + 1) * 64 + 4 * c4);
            a0 += (w0[0] * mr[4 * c4] + w0[1] * mr[4 * c4 + 1]) + (w0[2] * mr[4 * c4 + 2] + w0[3] * mr[4 * c4 + 3]);
            a1 += (w1[0] * mr[4 * c4] + w1[1] * mr[4 * c4 + 1]) + (w1[2] * mr[4 * c4 + 2] + w1[3] * mr[4 * c4 + 3]); }
        *(unsigned*)(orow + k) = pk2(a0, a1); }
    asm volatile("s_waitcnt lgkmcnt(0)" ::: "memory");
}

__device__ __forceinline__ void p0_adaln_item(const float* c, const float* c_ctx, const float* w_ada, const float* b_ada, float* mod, int l, int cb, int ks, LAS float* sv, int lane) {
    const int col0 = cb * 256 + lane * 4;
    for (int e = lane; e < 160; e += 64) { const int r = e >> 5, k = ks * 32 + (e & 31); const float v = r < 4 ? c[r * 1024 + k] : c_ctx[k]; sv[e] = v / (1.0f + __expf(-v)); }
    f32x4 w[32];
    const float* wp = w_ada + ((size_t)l * 1024 + ks * 32) * 6144 + col0;
#pragma unroll
    for (int kk = 0; kk < 32; ++kk) w[kk] = *(const f32x4*)(wp + (size_t)kk * 6144);
    asm volatile("s_waitcnt lgkmcnt(0)" ::: "memory");
    f32x4 acc[5];
#pragma unroll
    for (int r = 0; r < 5; ++r) acc[r] = (f32x4){0.f, 0.f, 0.f, 0.f};
#pragma unroll
    for (int kk = 0; kk < 32; ++kk)
#pragma unroll
        for (int r = 0; r < 5; ++r) acc[r] += sv[r * 32 + kk] * w[kk];
    if (ks == 0) { const f32x4 b = *(const f32x4*)(b_ada + l * 6144 + col0);
#pragma unroll
        for (int r = 0; r < 5; ++r) acc[r] += b; }
    LAS float* tr = sv + 192;
#pragma unroll
    for (int r = 0; r < 5; ++r) *(LAS f32x4*)(tr + r * 256 + lane * 4) = acc[r];
    asm volatile("s_waitcnt lgkmcnt(0)" ::: "memory");
#pragma unroll
    for (int r = 0; r < 5; ++r)
#pragma unroll
        for (int j = 0; j < 4; ++j) atomicAdd(mod + (size_t)(l * 5 + r) * 6144 + cb * 256 + j * 64 + lane, tr[r * 256 + j * 64 + lane]);
    asm volatile("s_waitcnt lgkmcnt(0)" ::: "memory");
}

__device__ __forceinline__ void normmod_row(const float* xrow, const float* gain, const float* sh, const float* sc, bf16_t* orow, int lane) {
    f32x4 v[4]; float ss = 0.f;
#pragma unroll
    for (int j = 0; j < 4; ++j) { v[j] = *(const f32x4*)(xrow + lane * 4 + 256 * j); ss += (v[j][0] * v[j][0] + v[j][1] * v[j][1]) + (v[j][2] * v[j][2] + v[j][3] * v[j][3]); }
    const float rs = rsqrtf(wave_sum(ss) * (1.0f / D) + RMS_EPS);
#pragma unroll
    for (int j = 0; j < 4; ++j) { const int idx = lane * 4 + 256 * j; const f32x4 g = *(const f32x4*)(gain + idx), a = *(const f32x4*)(sc + idx), b = *(const f32x4*)(sh + idx);
        const f32x4 o = v[j] * rs * g * (1.0f + a) + b;
        u32x2 w; w.x = pk2(o[0], o[1]); w.y = pk2(o[2], o[3]); *(u32x2*)(orow + idx) = w; }
}

struct SchedZ { const char* WZ; const char* XN; int vcu;
    __device__ __forceinline__ bool next(int i, Unit& u) const { if (i > 0) return false; const int x = vcu >> 5, q = vcu & 31; const int tt = 8 * x + (q >> 2), zp = q & 3;
        u.a = WZ + (size_t)zp * 256 * D * 2; u.b = XN + ((size_t)(tt >> 4) * S + 4 * (tt & 15)) * D * 2; u.i0 = tt; u.i1 = zp; u.i2 = 0; u.i3 = 0; return true; } };
struct SchedQKV { const char* XN; const char* W; int vcu; int full_ctx;
    __device__ __forceinline__ bool next(int i, Unit& u) const { if (i > 0) return false; const int x = vcu >> 5, q = vcu & 31; int tile, pn;
        if (q < 24) { tile = 8 * x + q / 3; pn = q % 3; }
        else { const int e = x * 8 + (q - 24); if (full_ctx) { if (e >= 12) return false; tile = 64 + e / 3; pn = e % 3; } else { if (e >= 4) return false; tile = 64 + e; pn = 2; } }
        u.a = XN + (size_t)tile * 256 * D * 2; u.b = W + (size_t)pn * 256 * D * 2; u.i0 = tile; u.i1 = pn; u.i2 = 0; u.i3 = 0; return true; } };
struct SchedZc { const char* WZ; const char* XN; int vcu;
    __device__ __forceinline__ bool next(int i, Unit& u) const { if (i > 0) return false; const int x = vcu >> 5, q = vcu & 31; if (q < 24) return false; const int e = x * 8 + (q - 24) - 12; if (e < 0 || e >= 16) return false;
        const int cb = e >> 2, zp = e & 3; u.a = WZ + (size_t)zp * 256 * D * 2; u.b = XN + ((size_t)MLAT + cb * 256) * D * 2; u.i0 = cb; u.i1 = zp; u.i2 = 0; u.i3 = 0; return true; } };

struct EpiQKV {
    static constexpr bool PERM = true, AFTER_DRAIN = false;
    bf16_t* Q; bf16_t* Kb; bf16_t* Vb; const float* rope;
    __device__ __forceinline__ void operator()(const f32x4 (&acc)[2][2][4][2], const Unit& u, int wr, int wc, int fr, int fq) const {
        const int tile = u.i0, pn = u.i1; const bool lat = tile < 64;
#pragma unroll
        for (int ai = 0; ai < 2; ++ai)
#pragma unroll
            for (int m = 0; m < 4; ++m) { const int row = tile * 256 + ai * HALF + wr * 64 + m * 16 + fr; const int t = row & (S - 1), gr = t >> 6, gc = t & 63;
#pragma unroll
                for (int bj = 0; bj < 2; ++bj) { const int colt = bj * HALF + wc * 32 + 8 * fq; f32x4 v0 = acc[ai][bj][m][0], v1 = acc[ai][bj][m][1];
                    const bool isV = (pn == 2) && (bj == 1);
                    if (lat && !isV) { const int i0 = (colt & 63) >> 1; const int pos = i0 < 16 ? gr : gc; const f32x4* tp = (const f32x4*)(rope + (size_t)(pos * 16 + (i0 & 15)) * 2);
                        const f32x4 c01 = tp[0], c23 = tp[1];
                        v0 = (f32x4){v0[0] * c01[0] - v0[1] * c01[1], v0[0] * c01[1] + v0[1] * c01[0], v0[2] * c01[2] - v0[3] * c01[3], v0[2] * c01[3] + v0[3] * c01[2]};
                        v1 = (f32x4){v1[0] * c23[0] - v1[1] * c23[1], v1[0] * c23[1] + v1[1] * c23[0], v1[2] * c23[2] - v1[3] * c23[3], v1[2] * c23[3] + v1[3] * c23[2]}; }
                    bf16_t* dst;
                    if (pn < 2) { v0 = v0 * C2; v1 = v1 * C2; dst = Q + (size_t)row * 512 + pn * 256 + colt; }
                    else if (bj == 0) dst = Kb + (size_t)row * 128 + colt;
                    else dst = Vb + (size_t)row * 128 + (colt - 128);
                    u32x4 w; w.x = cvt_pk_bf16(v0[0], v0[1]); w.y = cvt_pk_bf16(v0[2], v0[3]); w.z = cvt_pk_bf16(v1[0], v1[1]); w.w = cvt_pk_bf16(v1[2], v1[3]);
                    *(u32x4*)dst = w; } }
    }
};
struct EpiZ {
    static constexpr bool PERM = true, AFTER_DRAIN = false;
    bf16_t* ZT;
    __device__ __forceinline__ void operator()(const f32x4 (&acc)[2][2][4][2], const Unit& u, int wr, int wc, int fr, int fq) const {
        const int tt = u.i0, zp = u.i1, b = tt >> 4, n2_0 = (tt & 15) * 4, type = zp >> 1;
#pragma unroll
        for (int ai = 0; ai < 2; ++ai)
#pragma unroll
            for (int m = 0; m < 4; ++m) { const int ch = (zp & 1) * 256 + ai * HALF + wr * 64 + m * 16 + fr; bf16_t* base = ZT + (((size_t)ch * 4 + b) * 2 + type) * 4096;
#pragma unroll
                for (int bj = 0; bj < 2; ++bj) { const int j = bj * HALF + wc * 32 + 8 * fq; const int n2 = n2_0 + (j >> 6), n1 = j & 63; const f32x4 v0 = acc[ai][bj][m][0], v1 = acc[ai][bj][m][1];
                    u32x4 w; w.x = cvt_pk_bf16(v0[0], v0[1]); w.y = cvt_pk_bf16(v0[2], v0[3]); w.z = cvt_pk_bf16(v1[0], v1[1]); w.w = cvt_pk_bf16(v1[2], v1[3]);
                    *(u32x4*)(base + n2 * 64 + n1) = w; } }
    }
};
struct EpiZc {
    static constexpr bool PERM = true, AFTER_DRAIN = false;
    bf16_t* ZTc;
    __device__ __forceinline__ void operator()(const f32x4 (&acc)[2][2][4][2], const Unit& u, int wr, int wc, int fr, int fq) const {
        const int b = u.i0, zp = u.i1, type = zp >> 1;
#pragma unroll
        for (int ai = 0; ai < 2; ++ai)
#pragma unroll
            for (int m = 0; m < 4; ++m) { const int ch = (zp & 1) * 256 + ai * HALF + wr * 64 + m * 16 + fr; bf16_t* base = ZTc + (((size_t)b * 512 + ch) * 2 + type) * 256;
#pragma unroll
                for (int bj = 0; bj < 2; ++bj) { const int j = bj * HALF + wc * 32 + 8 * fq; const f32x4 v0 = acc[ai][bj][m][0], v1 = acc[ai][bj][m][1];
                    u32x4 w; w.x = cvt_pk_bf16(v0[0], v0[1]); w.y = cvt_pk_bf16(v0[2], v0[3]); w.z = cvt_pk_bf16(v1[0], v1[1]); w.w = cvt_pk_bf16(v1[2], v1[3]);
                    *(u32x4*)(base + j) = w; } }
    }
};
namespace att {
constexpr int KT_BYTES = 8192, BUF_BYTES = 2 * KT_BYTES, LDS_WS = 2 * BUF_BYTES;
constexpr int LDS_BYTES_ATT = LDS_WS + 8 * 256;
__device__ __forceinline__ int crow(int r, int hi) { return (r & 3) + 8 * (r >> 2) + 4 * hi; }
typedef short s16x4 __attribute__((ext_vector_type(4)));
__device__ __forceinline__ s16x4 vtr(const LAS unsigned char* p) { return __builtin_bit_cast(s16x4, __builtin_amdgcn_ds_read_tr16_b64_v4i16((LAS s16x4*)p)); }
__device__ __forceinline__ void hswap(unsigned& a, unsigned& b) { asm volatile("s_nop 1\n\tv_permlane32_swap_b32 %0, %1" : "+v"(a), "+v"(b)); }
__device__ __forceinline__ float hswap_max(float v) { unsigned a = __builtin_bit_cast(unsigned, v), b = a; hswap(a, b); return fmaxf(__builtin_bit_cast(float, a), __builtin_bit_cast(float, b)); }
__device__ __forceinline__ float hswap_sum(float v) { unsigned a = __builtin_bit_cast(unsigned, v), b = a; hswap(a, b); return __builtin_bit_cast(float, a) + __builtin_bit_cast(float, b); }

__device__ __forceinline__ void attn_unit(LAS unsigned char* lds, const bf16_t* Q, const bf16_t* Kb, const bf16_t* Vb, bf16_t* AO, const float* sinkl,
                                          int qrow0, int kvh, int krow_ctx, int krow_lat, int qb) {
    const int tid = threadIdx.x, lane = tid & 63, r32 = lane & 31, hi = lane >> 5; const int wid = __builtin_amdgcn_readfirstlane(tid >> 6);
    const int g = wid >> 1, half = wid & 1, h = kvh * 4 + g;
    LAS float* wsf = (LAS float*)(lds + LDS_WS) + wid * 64;
    int jlo = 0, jhi = -1;
    if (krow_lat >= 0) { jlo = qb - 2 < 0 ? 0 : qb - 2; jhi = qb + 2 > 63 ? 63 : qb + 2; }
    const int NT = 4 + (jhi - jlo + 1);
    const bf16_t* Qw = Q + (size_t)(qrow0 + 32 * half + r32) * 512 + h * 64;
    bf16x8 qr[4];
#pragma unroll
    for (int d0 = 0; d0 < 4; ++d0) qr[d0] = *(const bf16x8*)(Qw + d0 * 16 + hi * 8);
    const int krow_of_lane = lane, vrow_of_lane = 16 * (wid & 3) + (lane >> 2);
    const size_t koff = (size_t)krow_of_lane * 128 + kvh * 64 + wid * 8;
    const size_t voff = (size_t)vrow_of_lane * 128 + kvh * 64 + (wid >> 2) * 32 + (lane & 3) * 8;
    const int sdst = wid * 1024 + lane * 16;
    auto tile_row = [&](int t) -> int { return t < 4 ? krow_ctx + 64 * t : krow_lat + 64 * (jlo + t - 4); };
    u32x4 kreg, vreg;
    { const int kr = tile_row(0); kreg = *(const u32x4*)(Kb + (size_t)kr * 128 + koff); vreg = *(const u32x4*)(Vb + (size_t)kr * 128 + voff); }
    *(LAS u32x4*)(lds + sdst) = kreg; *(LAS u32x4*)(lds + KT_BYTES + sdst) = vreg;
    __syncthreads();
    float m_run = -1e30f, l_run = 0.f;
    f32x16 o0 = {}, o1 = {};
    const int qtok = 64 * qb + 32 * half + r32;
    for (int t = 0; t < NT; ++t) {
        const LAS unsigned char* kb_ = lds + (t & 1) * BUF_BYTES; const LAS unsigned char* vb_ = kb_ + KT_BYTES;
        if (t + 1 < NT) { const int kr = tile_row(t + 1); kreg = *(const u32x4*)(Kb + (size_t)kr * 128 + koff); vreg = *(const u32x4*)(Vb + (size_t)kr * 128 + voff); }
        f32x16 p0 = {}, p1 = {};
        { const LAS unsigned char* kp = kb_ + hi * 1024 + r32 * 16;
#pragma unroll
          for (int d0 = 0; d0 < 4; ++d0) { const bf16x8 a0 = *(const LAS bf16x8*)(kp + d0 * 2048), a1 = *(const LAS bf16x8*)(kp + d0 * 2048 + 512);
              p0 = __builtin_amdgcn_mfma_f32_32x32x16_bf16(a0, qr[d0], p0, 0, 0, 0); p1 = __builtin_amdgcn_mfma_f32_32x32x16_bf16(a1, qr[d0], p1, 0, 0, 0); } }
        if (t >= 4) { const int jt = jlo + t - 4; const int dq = jt - qb;
            if (dq == 2 || dq == -2) { const int kbase = 64 * jt + 4 * hi - qtok;
#pragma unroll
                for (int r = 0; r < 16; ++r) { const int dj = kbase + (r & 3) + 8 * (r >> 2);
                    if (dj < -128 || dj > 128) p0[r] = -1e30f; if (dj + 32 < -128 || dj + 32 > 128) p1[r] = -1e30f; } } }
        float mx = fmaxf(p0[0], p1[0]);
#pragma unroll
        for (int r = 1; r < 16; ++r) mx = fmaxf(mx, fmaxf(p0[r], p1[r]));
        mx = hswap_max(mx);
        const float mnew = fmaxf(m_run, mx); const float alpha = __builtin_amdgcn_exp2f(m_run - mnew); m_run = mnew;
        float ps = 0.f;
#pragma unroll
        for (int r = 0; r < 16; ++r) { p0[r] = __builtin_amdgcn_exp2f(p0[r] - mnew); p1[r] = __builtin_amdgcn_exp2f(p1[r] - mnew); ps += p0[r] + p1[r]; }
        l_run = l_run * alpha + ps;
        if (hi == 0) wsf[r32] = alpha;
        asm volatile("s_waitcnt lgkmcnt(0)" ::: "memory");
#pragma unroll
        for (int r = 0; r < 16; ++r) { const float f = wsf[crow(r, hi)]; o0[r] *= f; o1[r] *= f; }
        u32x4 pa[4];
#pragma unroll
        for (int s = 0; s < 2; ++s) {
            pa[s]     = (u32x4){cvtpk_s(p0[8 * s], p0[8 * s + 1]), cvtpk_s(p0[8 * s + 2], p0[8 * s + 3]), cvtpk_s(p0[8 * s + 4], p0[8 * s + 5]), cvtpk_s(p0[8 * s + 6], p0[8 * s + 7])};
            pa[2 + s] = (u32x4){cvtpk_s(p1[8 * s], p1[8 * s + 1]), cvtpk_s(p1[8 * s + 2], p1[8 * s + 3]), cvtpk_s(p1[8 * s + 4], p1[8 * s + 5]), cvtpk_s(p1[8 * s + 6], p1[8 * s + 7])}; }
        { const LAS unsigned char* vp = vb_ + ((lane >> 4) & 1) * 32 + (lane & 3) * 8 + (4 * hi + ((lane & 15) >> 2)) * 64;
#pragma unroll
          for (int ks = 0; ks < 4; ++ks) {
              const s16x4 l0 = vtr(vp + ks * 1024), h0 = vtr(vp + ks * 1024 + 512), l1 = vtr(vp + 4096 + ks * 1024), h1 = vtr(vp + 4096 + ks * 1024 + 512);
              const bf16x8 v0 = (bf16x8){l0[0], l0[1], l0[2], l0[3], h0[0], h0[1], h0[2], h0[3]}, v1 = (bf16x8){l1[0], l1[1], l1[2], l1[3], h1[0], h1[1], h1[2], h1[3]};
              const bf16x8 pf = __builtin_bit_cast(bf16x8, pa[ks]);
              o0 = __builtin_amdgcn_mfma_f32_32x32x16_bf16(pf, v0, o0, 0, 0, 0); o1 = __builtin_amdgcn_mfma_f32_32x32x16_bf16(pf, v1, o1, 0, 0, 0); } }
        if (t + 1 < NT) { LAS unsigned char* nb = lds + ((t + 1) & 1) * BUF_BYTES; *(LAS u32x4*)(nb + sdst) = kreg; *(LAS u32x4*)(nb + KT_BYTES + sdst) = vreg; }
        __syncthreads();
    }
    float l_tot = hswap_sum(l_run) + __builtin_amdgcn_exp2f(sinkl[h] * 1.4426950408889634f - m_run);
    if (hi == 0) wsf[32 + r32] = 1.0f / l_tot;
    asm volatile("s_waitcnt lgkmcnt(0)" ::: "memory");
    bf16_t* Ow = AO + (size_t)(qrow0 + 32 * half) * D + h * 64 + r32;
#pragma unroll
    for (int r = 0; r < 16; ++r) { const int q = crow(r, hi); const float f = wsf[32 + q];
        Ow[(size_t)q * D] = (bf16_t)f2bf(o0[r] * f); Ow[(size_t)q * D + 32] = (bf16_t)f2bf(o1[r] * f); }
    __syncthreads();
}
}
namespace fft {
constexpr int ROWB = 272;
constexpr int T_M1R = 0, T_M1I = 64 * ROWB, T_M2P = 2 * 64 * ROWB, T_TW = 3 * 64 * ROWB, T_BYTES = T_TW + 1024;
constexpr int L_TAB = 0, L_STG = 53248, LDS_BYTES_FFT = L_STG + 65536;
__device__ __forceinline__ int crow(int r, int hi) { return (r & 3) + 8 * (r >> 2) + 4 * hi; }

__device__ __forceinline__ void gen_table_entry(unsigned char* tab, int e) {
    if (e < 3 * 8192) { const int mat = e >> 13, row = (e >> 7) & 63, col = e & 127; float v;
        if (mat < 2) { const int type = col >> 6, n1 = col & 63; float s, c; sincospif((float)((n1 * row) & 63) / 32.0f, &s, &c);
            v = mat == 0 ? (type == 0 ? c : -s) : (type == 0 ? -s : -c); }
        else {
            const int f = col >> 4, hh = (col >> 3) & 1, j = col & 7, ri = f >> 2, rb = (f >> 1) & 1, s_ = f & 1; const int n2 = 32 * rb + 16 * s_ + 8 * (j >> 2) + 4 * hh + (j & 3);
            float s, c; sincospif((float)((n2 * row) & 63) / 32.0f, &s, &c); v = ri == 0 ? c : s; }
        *(bf16_t*)(tab + mat * 64 * ROWB + row * ROWB + col * 2) = (bf16_t)f2bf(v); }
    else { const int t = e - 3 * 8192; if (t < 128) { float s, c; if (t < 64) sincospif((float)t / 32.0f, &s, &c); else sincospif((float)(t - 64) / 2048.0f, &s, &c);
        float* p = (float*)(tab + T_TW) + 2 * t; p[0] = c; p[1] = s; } }
}

__device__ __forceinline__ void fft_load_tables(LAS unsigned char* lds, const unsigned char* tab) {
    for (int i = threadIdx.x; i < T_BYTES / 16; i += NWAVES * 64) *(LAS u32x4*)(lds + L_TAB + i * 16) = *(const u32x4*)(tab + i * 16);
}

__device__ __forceinline__ void fft_unit(LAS unsigned char* lds, const bf16_t* ZT, bf16_t* AO, int b, int chg) {
    const int tid = threadIdx.x, lane = tid & 63, r32 = lane & 31, hi = lane >> 5; const int wid = __builtin_amdgcn_readfirstlane(tid >> 6);
    const int ch = chg * 8 + wid;
    const bf16_t* zb = ZT + ((size_t)ch * 4 + b) * 2 * 4096;
    const LAS unsigned char* tM1r = lds + L_TAB + T_M1R; const LAS unsigned char* tM1i = lds + L_TAB + T_M1I; const LAS unsigned char* tM2 = lds + L_TAB + T_M2P;
    const LAS f32x2* TH = (const LAS f32x2*)(lds + L_TAB + T_TW); const LAS f32x2* TL = TH + 64;
    f32x16 out[2][2];
#pragma unroll
    for (int a = 0; a < 2; ++a)
#pragma unroll
        for (int c = 0; c < 2; ++c) out[a][c] = (f32x16){};
#pragma unroll
    for (int rb = 0; rb < 2; ++rb) {
        f32x16 Tr[2], Ti[2];
        Tr[0] = (f32x16){}; Tr[1] = (f32x16){}; Ti[0] = (f32x16){}; Ti[1] = (f32x16){};
        bf16x8 xa[8];
#pragma unroll
        for (int ks = 0; ks < 8; ++ks) xa[ks] = *(const bf16x8*)(zb + (size_t)(ks >> 2) * 4096 + (32 * rb + r32) * 64 + 16 * (ks & 3) + 8 * hi);
#pragma unroll
        for (int ks = 0; ks < 8; ++ks) {
#pragma unroll
            for (int cb = 0; cb < 2; ++cb) { const int boff = (32 * cb + r32) * ROWB + (16 * ks + 8 * hi) * 2;
                const bf16x8 br = *(const LAS bf16x8*)(tM1r + boff), bi = *(const LAS bf16x8*)(tM1i + boff);
                Tr[cb] = __builtin_amdgcn_mfma_f32_32x32x16_bf16(xa[ks], br, Tr[cb], 0, 0, 0); Ti[cb] = __builtin_amdgcn_mfma_f32_32x32x16_bf16(xa[ks], bi, Ti[cb], 0, 0, 0); } }
        u32x4 fr_[2][2][2];
#pragma unroll
        for (int cb = 0; cb < 2; ++cb) { const int k1 = 32 * cb + r32; float tr[16], ti[16];
#pragma unroll
            for (int r = 0; r < 16; ++r) { const int n2 = 32 * rb + crow(r, hi); const int m = n2 * k1; const f32x2 a = TH[m >> 6], bb = TL[m & 63];
                const float c = a[0] * bb[0] - a[1] * bb[1], s = a[1] * bb[0] + a[0] * bb[1];
                tr[r] = Tr[cb][r] * c + Ti[cb][r] * s; ti[r] = Ti[cb][r] * c - Tr[cb][r] * s; }
#pragma unroll
            for (int s_ = 0; s_ < 2; ++s_) {
                fr_[0][cb][s_] = (u32x4){cvt_pk_bf16(tr[8 * s_], tr[8 * s_ + 1]), cvt_pk_bf16(tr[8 * s_ + 2], tr[8 * s_ + 3]), cvt_pk_bf16(tr[8 * s_ + 4], tr[8 * s_ + 5]), cvt_pk_bf16(tr[8 * s_ + 6], tr[8 * s_ + 7])};
                fr_[1][cb][s_] = (u32x4){cvt_pk_bf16(ti[8 * s_], ti[8 * s_ + 1]), cvt_pk_bf16(ti[8 * s_ + 2], ti[8 * s_ + 3]), cvt_pk_bf16(ti[8 * s_ + 4], ti[8 * s_ + 5]), cvt_pk_bf16(ti[8 * s_ + 6], ti[8 * s_ + 7])}; } }
#pragma unroll
        for (int ri = 0; ri < 2; ++ri)
#pragma unroll
            for (int s_ = 0; s_ < 2; ++s_) { const int f = (ri * 2 + rb) * 2 + s_;
#pragma unroll
                for (int kb = 0; kb < 2; ++kb) { const bf16x8 am = *(const LAS bf16x8*)(tM2 + (32 * kb + r32) * ROWB + f * 32 + hi * 16);
#pragma unroll
                    for (int cb = 0; cb < 2; ++cb) out[kb][cb] = __builtin_amdgcn_mfma_f32_32x32x16_bf16(am, __builtin_bit_cast(bf16x8, fr_[ri][cb][s_]), out[kb][cb], 0, 0, 0); } }
    }
    LAS bf16_t* stg = (LAS bf16_t*)(lds + L_STG);
#pragma unroll
    for (int kb = 0; kb < 2; ++kb)
#pragma unroll
        for (int cb = 0; cb < 2; ++cb)
#pragma unroll
            for (int r = 0; r < 16; ++r) { const int k2 = 32 * kb + crow(r, hi), k1 = 32 * cb + r32; stg[(k1 + 64 * k2) * 8 + wid] = (bf16_t)f2bf(out[kb][cb][r]); }
    __syncthreads();
    bf16_t* ob = AO + (size_t)b * S * D + 512 + chg * 8;
    for (int n = tid; n < S; n += NWAVES * 64) *(u32x4*)(ob + (size_t)n * D) = *(const LAS u32x4*)(lds + L_STG + n * 16);
    __syncthreads();
}
}

struct EpiBf16 {
    static constexpr bool PERM = true, AFTER_DRAIN = false;
    bf16_t* O; int ldc;
    __device__ __forceinline__ void operator()(const f32x4 (&acc)[2][2][4][2], const Unit& u, int wr, int wc, int fr, int fq) const {
        bf16_t* base = O + (size_t)u.i2 + (size_t)(u.i0 * 256 + wr * 64 + fr) * ldc + u.i1 * 256 + wc * 32 + 8 * fq;
#pragma unroll
        for (int ai = 0; ai < 2; ++ai)
#pragma unroll
            for (int m = 0; m < 4; ++m)
#pragma unroll
                for (int bj = 0; bj < 2; ++bj) { const f32x4 v0 = acc[ai][bj][m][0], v1 = acc[ai][bj][m][1];
                    u32x4 w; w.x = cvt_pk_bf16(v0[0], v0[1]); w.y = cvt_pk_bf16(v0[2], v0[3]); w.z = cvt_pk_bf16(v1[0], v1[1]); w.w = cvt_pk_bf16(v1[2], v1[3]);
                    *(u32x4*)(base + (size_t)(ai * HALF + m * 16) * ldc + bj * HALF) = w; }
    }
};
struct SchedFc { const char* Dc; const char* ZTc; int vcu;
    __device__ __forceinline__ bool next(int i, Unit& u) const { if (i > 0 || (vcu & 7) != 4 || (vcu >> 3) >= 8) return false; const int e = vcu >> 3, b = e >> 1, pn = e & 1;
        u.a = Dc; u.b = ZTc + ((size_t)b * 512 + pn * 256) * 512 * 2; u.i0 = 0; u.i1 = pn; u.i2 = (MLAT + b * 256) * D + 512; u.i3 = 0; return true; } };
struct SchedMN { const char* A; const char* B; int K, nM, nN, G, c;
    __device__ __forceinline__ bool next(int i, Unit& u) const {
        const int nwg = nM * nN; const long L = (long)i * G + c; if (L >= nwg) return false;
        int wgid = (int)L; { const int q = nwg / 8, r = nwg % 8, xcd = wgid % 8, off = wgid / 8; wgid = (xcd < r ? xcd * (q + 1) : r * (q + 1) + (xcd - r) * q) + off; }
        const int nig = 8 * nN, gid = wgid / nig, fm = gid * 8, gsz = (nM - fm) < 8 ? (nM - fm) : 8;
        const int pm = fm + ((wgid % nig) % gsz), pn = (wgid % nig) / gsz;
        u.a = A + (size_t)pm * 256 * K * 2; u.b = B + (size_t)pn * 256 * K * 2; u.i0 = pm; u.i1 = pn; u.i2 = 0; u.i3 = 0; return true; } };

struct EpiF32 {
    static constexpr bool PERM = false, AFTER_DRAIN = false;
    float* C; int ldc;
    __device__ __forceinline__ void operator()(const f32x4 (&acc)[2][2][4][2], const Unit& u, int wr, int wc, int fr, int fq) const {
        const int row0 = u.i0 * BM + wr * 64 + fr, col0 = u.i1 * BM + wc * 32 + 4 * fq;
#pragma unroll
        for (int ai = 0; ai < 2; ++ai)
#pragma unroll
            for (int m = 0; m < 4; ++m) { float* rowp = C + (size_t)(row0 + ai * HALF + m * 16) * ldc + col0;
#pragma unroll
                for (int bj = 0; bj < 2; ++bj)
#pragma unroll
                    for (int n = 0; n < 2; ++n) *(f32x4*)(rowp + bj * HALF + n * 16) = acc[ai][bj][m][n]; }
    }
};
struct EpiSwiGLU {
    static constexpr bool PERM = true, AFTER_DRAIN = false;
    bf16_t* Hd;
    __device__ __forceinline__ void operator()(const f32x4 (&acc)[2][2][4][2], const Unit& u, int wr, int wc, int fr, int fq) const {
        bf16_t* base = Hd + (size_t)(u.i0 * BM + wr * 64 + fr) * FF + u.i1 * HALF + wc * 32 + 8 * fq;
#pragma unroll
        for (int ai = 0; ai < 2; ++ai)
#pragma unroll
            for (int m = 0; m < 4; ++m) { float o[8];
#pragma unroll
                for (int n = 0; n < 2; ++n)
#pragma unroll
                    for (int j = 0; j < 4; ++j) { const float g = acc[ai][0][m][n][j], up = acc[ai][1][m][n][j];
                        const float sg = __builtin_amdgcn_rcpf(1.0f + __builtin_amdgcn_exp2f(-1.4426950408889634f * g)); o[4 * n + j] = g * sg * up; }
                u32x4 w; w.x = pk2(o[0], o[1]); w.y = pk2(o[2], o[3]); w.z = pk2(o[4], o[5]); w.w = pk2(o[6], o[7]);
                *(u32x4*)(base + (size_t)(ai * HALF + m * 16) * FF) = w; }
    }
};

__device__ __forceinline__ void post_row(const float* yrow, const float* xirow, float* xorow, const float* gain, const float* gate,
                                         bool do_xn, const float* gain2, const float* sh, const float* sc, bf16_t* xnrow, int lane) {
    f32x4 y[4], x[4]; float ss = 0.f;
#pragma unroll
    for (int j = 0; j < 4; ++j) { y[j] = *(const f32x4*)(yrow + lane * 4 + 256 * j); x[j] = *(const f32x4*)(xirow + lane * 4 + 256 * j);
        ss += (y[j][0] * y[j][0] + y[j][1] * y[j][1]) + (y[j][2] * y[j][2] + y[j][3] * y[j][3]); }
    const float rs = rsqrtf(wave_sum(ss) * (1.0f / D) + RMS_EPS);
    float s2 = 0.f;
#pragma unroll
    for (int j = 0; j < 4; ++j) { const int idx = lane * 4 + 256 * j; const f32x4 g = *(const f32x4*)(gain + idx), a = *(const f32x4*)(gate + idx);
        x[j] = x[j] + a * (y[j] * rs * g); *(f32x4*)(xorow + idx) = x[j];
        s2 += (x[j][0] * x[j][0] + x[j][1] * x[j][1]) + (x[j][2] * x[j][2] + x[j][3] * x[j][3]); }
    if (do_xn) { const float r2 = rsqrtf(wave_sum(s2) * (1.0f / D) + RMS_EPS);
#pragma unroll
        for (int j = 0; j < 4; ++j) { const int idx = lane * 4 + 256 * j; const f32x4 g = *(const f32x4*)(gain2 + idx), a = *(const f32x4*)(sc + idx), b = *(const f32x4*)(sh + idx);
            const f32x4 o = x[j] * r2 * g * (1.0f + a) + b; u32x2 w; w.x = pk2(o[0], o[1]); w.y = pk2(o[2], o[3]); *(u32x2*)(xnrow + idx) = w; } }
}
#define XB_TMO      128
#define XB_XCNT(j)  (256  + 64 * (j))
#define XB_XSUB(j)  (1280 + 64 * (j))
#define XB_XGEN(j)  (2304 + 64 * (j))
#define XB_TOP      3328
#define XB_TOPGEN   3392
#define XCD_BAR_WORDS 3456
#define XB_SPIN_CAP (1u << 18)
__device__ __forceinline__ unsigned xb_ld(unsigned* p)              { return __hip_atomic_load(p, __ATOMIC_RELAXED, __HIP_MEMORY_SCOPE_AGENT); }
__device__ __forceinline__ unsigned xb_add(unsigned* p, unsigned v) { return __hip_atomic_fetch_add(p, v, __ATOMIC_RELAXED, __HIP_MEMORY_SCOPE_AGENT); }
__device__ __forceinline__ unsigned xb_xcc_id() { return (unsigned)__builtin_amdgcn_s_getreg((3 << 11) | 20) & 0xFu; }
#define XB_SPIN(cond, bar) do { unsigned _sp = 0; while (cond) { __builtin_amdgcn_s_sleep(1); \
    if ((++_sp & 255u) == 0u) { if (xb_ld(&(bar)[XB_TMO])) break; if (_sp > XB_SPIN_CAP) { atomicAdd(&(bar)[XB_TMO], 1u); break; } } } } while (0)
struct XcdBarrier { unsigned* bar; unsigned x; volatile LAS unsigned* st; };
__device__ __forceinline__ XcdBarrier xcd_barrier_post(unsigned* bar, volatile LAS unsigned* st) {
    XcdBarrier b; b.bar = bar; b.x = xb_xcc_id(); b.st = st;
    if (threadIdx.x == 0) (void)xb_add(&bar[XB_XCNT(b.x)], 1u);
    return b;
}
__device__ __forceinline__ void xcd_barrier_complete(unsigned* bar, unsigned x, unsigned& nloc, unsigned& nx) {
    const unsigned G = gridDim.x * gridDim.y * gridDim.z;
    unsigned sum, cnt, mine, sp = 0u;
    for (;;) {
        sum = 0u; cnt = 0u; mine = 0u;
#pragma unroll
        for (unsigned j = 0; j < 16; ++j) { const unsigned c = xb_ld(&bar[XB_XCNT(j)]); sum += c; cnt += (c > 0u) ? 1u : 0u; mine = (j == x) ? c : mine; }
        if (sum == G) break;
        __builtin_amdgcn_s_sleep(1);
        if ((++sp & 255u) == 0u) { if (xb_ld(&bar[XB_TMO])) break; if (sp > XB_SPIN_CAP) { atomicAdd(&bar[XB_TMO], 1u); break; } }
    }
    nloc = mine > 0u ? mine : 1u; nx = cnt > 0u ? cnt : 1u;
}
__device__ __forceinline__ void xcd_barrier(const XcdBarrier& b) {
    asm volatile("s_waitcnt vmcnt(0)" ::: "memory");
    __syncthreads();
    if (threadIdx.x == 0) {
        unsigned* bar = b.bar;
        __builtin_amdgcn_s_waitcnt(0);
        unsigned nloc = b.st[0], nx = b.st[1];
        if (nloc == 0u) { xcd_barrier_complete(bar, b.x, nloc, nx); b.st[0] = nloc; b.st[1] = nx; }
        const unsigned old = xb_add(&bar[XB_XSUB(b.x)], 1u);
        const unsigned gen = old / nloc;
        if (old + 1u == (gen + 1u) * nloc) {
            __builtin_amdgcn_fence(__ATOMIC_RELEASE, "agent");
            asm volatile("s_waitcnt vmcnt(0)" ::: "memory");
            const unsigned og = xb_add(&bar[XB_TOP], 1u);
            const unsigned tg = og / nx;
            if (og + 1u == (tg + 1u) * nx) xb_add(&bar[XB_TOPGEN], 1u);
            else XB_SPIN(xb_ld(&bar[XB_TOPGEN]) == tg, bar);
            __builtin_amdgcn_fence(__ATOMIC_ACQUIRE, "agent");
            xb_add(&bar[XB_XGEN(b.x)], 1u);
            asm volatile("s_waitcnt vmcnt(0)" ::: "memory");
        } else {
            XB_SPIN(xb_ld(&bar[XB_XGEN(b.x)]) == gen, bar);
            __builtin_amdgcn_fence(__ATOMIC_ACQUIRE, "agent");
            asm volatile("s_waitcnt vmcnt(0)" ::: "memory");
        }
    }
    __syncthreads();
}

constexpr int RING_BYTES = 131072, PRO_TB_OFF = RING_BYTES, LDSCTL_OFF = PRO_TB_OFF + 8 * 256, MISC_OFF = LDSCTL_OFF + 320, LDS_BYTES = 147456;
constexpr size_t TAB_FFT = 16384, TAB_DC = 131072, TAB_FM = 393216;
constexpr int CW_BAR = 4096;
constexpr int N_PHASES = 16;
enum { SUB_INPROJ = 0, SUB_MIX = 1, SUB_OUT = 2, SUB_POST1 = 3, SUB_GATEUP = 4, SUB_DOWN = 5, SUB_POST2 = 6 };

struct Ctx {
    Frame F; unsigned char* ws; const float* const* in; float* out;
    const float *x_in, *c_in, *ctx_in, *c_ctx, *w_ada, *b_ada, *npm, *npo, *npf, *npof, *w_in, *w_out, *w_four, *w_gate, *w_up, *w_down, *sink;
    float *mod, *rope, *Y, *XC; unsigned char* tabs;
    bf16_t *XN, *Qb, *Kb, *Vb, *ZT, *ZTc, *AO, *HID;
    int gw, NGW, p0sel;
};
template <int ph> __device__ __forceinline__ void run_phase(const Ctx& c) {
    constexpr int l = ph < 2 ? 0 : (ph - 2) / 7; constexpr int sub = ph < 2 ? -1 : (ph - 2) % 7;
    const Frame& F = c.F; unsigned char* ws = c.ws; float* out = c.out;
    const float *x_in = c.x_in, *c_in = c.c_in, *ctx_in = c.ctx_in, *c_ctx = c.c_ctx, *w_ada = c.w_ada, *b_ada = c.b_ada, *npm = c.npm, *npo = c.npo, *npf = c.npf, *npof = c.npof;
    const float *w_in = c.w_in, *w_out = c.w_out, *w_four = c.w_four, *w_gate = c.w_gate, *w_up = c.w_up, *w_down = c.w_down;
    float *mod = c.mod, *rope = c.rope, *Y = c.Y, *XC = c.XC; unsigned char* tabs = c.tabs;
    bf16_t *XN = c.XN, *Qb = c.Qb, *Kb = c.Kb, *Vb = c.Vb, *ZT = c.ZT, *ZTc = c.ZTc, *AO = c.AO, *HID = c.HID;
    const int gw = c.gw, NGW = c.NGW;
        const char* wl = (const char*)(ws + WS_W + (size_t)l * W_LSTRIDE);
        const int nMt = l == 0 ? 68 : 64;

        if constexpr (ph == 0) {
            LAS float* scr = (LAS float*)(F.lds + F.wave * 16384); LAS float* tb = (LAS float*)(F.lds + PRO_TB_OFF + F.wave * 256);
            constexpr int I_TR = 5120, I_FOLD = 128, I_ADA = 768, I_FT = 386, I_DC = 256;
            constexpr int NITEMS = 2 * (I_TR + I_FOLD + I_ADA) + 16 + I_FT + I_DC;
            for (int it = gw; it < NITEMS; it += NGW) {
                int r = it;
                { const int cls = r < 2 * I_TR ? 1 : (r < 2 * (I_TR + I_FOLD) ? 2 : (r < 2 * (I_TR + I_FOLD + I_ADA) ? 4 : 8)); if (c.p0sel != 0 && (c.p0sel & cls) == 0) continue; }
                if (r < 2 * I_TR) { const int ll = r / I_TR; r -= ll * I_TR; unsigned char* wll = ws + WS_W + (size_t)ll * W_LSTRIDE;
                    if (r < 384) { const int kb = r / 24, nb = r % 24; p0_tr_item(w_in + (size_t)ll * D * INW, INW, 64 * kb, 32 * nb, (bf16_t*)(wll + W_QKV), D, 32 * nb, scr, F.lane); continue; } r -= 384;
                    if (r < 512) { const int kb = r / 32, nb = r % 32; p0_tr_item(w_out + (size_t)ll * D * D, D, 64 * kb, 32 * nb, (bf16_t*)(wll + W_O), D, 32 * nb, scr, F.lane); continue; } r -= 512;
                    if (r < 1408) { const int kb = r / 88, nb = r % 88, n0 = 32 * nb; p0_tr_item(w_gate + (size_t)ll * D * FF, FF, 64 * kb, n0, (bf16_t*)(wll + W_GU), D, 256 * (n0 >> 7) + (n0 & 127), scr, F.lane); continue; } r -= 1408;
                    if (r < 1408) { const int kb = r / 88, nb = r % 88, n0 = 32 * nb; p0_tr_item(w_up + (size_t)ll * D * FF, FF, 64 * kb, n0, (bf16_t*)(wll + W_GU), D, 256 * (n0 >> 7) + 128 + (n0 & 127), scr, F.lane); continue; } r -= 1408;
                    { const int kb = r / 32, nb = r % 32; p0_tr_item(w_down + (size_t)ll * FF * D, D, 64 * kb, 32 * nb, (bf16_t*)(wll + W_D), FF, 32 * nb, scr, F.lane); }
                    continue; }
                r -= 2 * I_TR;
                if (r < 2 * I_FOLD) { const int ll = r / I_FOLD; r -= ll * I_FOLD; const int type = r >> 6, g = (r >> 3) & 7, cbk = r & 7;
                    p0_foldM_item(w_four + ((size_t)ll * 8 + g) * 4096, (float*)(tabs + TAB_FM) + (size_t)((ll * 2 + type) * 8 + g) * 4096, type, 8 * cbk, F.lane); continue; }
                r -= 2 * I_FOLD;
                if (r < 2 * I_ADA) { const int ll = r / I_ADA; r -= ll * I_ADA; p0_adaln_item(c_in, c_ctx, w_ada, b_ada, mod, ll, r >> 5, r & 31, scr, F.lane); continue; }
                r -= 2 * I_ADA;
                if (r >= 16) { r -= 16;
                    if (r < I_FT) { fft::gen_table_entry(tabs + TAB_FFT, r * 64 + F.lane); continue; }
                    r -= I_FT;
                    bf16_t* dc = (bf16_t*)(tabs + TAB_DC) + (size_t)r * 512;
                    for (int i = 0; i < 8; ++i) { const int col = F.lane + 64 * i, type = col >> 8, n = col & 255; float s_, c_; sincospif((float)((n * r) & 255) / 128.0f, &s_, &c_); dc[col] = (bf16_t)f2bf(type == 0 ? 4.0f * c_ : -4.0f * s_); }
                    continue; }
                { const int e = r * 64 + F.lane; const int pos = e >> 4, f = e & 15; const float fr_ = powf(10000.0f, -(float)f / 16.0f); const float a = (float)pos * fr_; rope[2 * e] = cosf(a); rope[2 * e + 1] = sinf(a); }
            }
        }
        else if constexpr (ph == 1) {
            { LAS float* scr = (LAS float*)(F.lds + F.wave * 16384);
              for (int it = gw; it < 2048; it += NGW) { const int ll = it >> 10, type = (it >> 9) & 1, g = (it >> 6) & 7, kb = it & 63;
                  p0_fold_item(w_in + (size_t)ll * D * INW, (const float*)(tabs + TAB_FM) + (size_t)((ll * 2 + type) * 8 + g) * 4096, (bf16_t*)(ws + WS_W + (size_t)ll * W_LSTRIDE + W_Z), type, g, 16 * kb, scr, F.lane); } }
            for (int m = gw; m < MT; m += NGW) {
                const float* src = m < MLAT ? x_in + (size_t)m * D : ctx_in + (size_t)(m - MLAT) * D;
                const int r = m < MLAT ? (m >> 12) : 4; const float* ml = mod + (size_t)r * 6144;
                normmod_row(src, npm, ml, ml + 1024, XN + (size_t)m * D, F.lane);
            }
        }
        else if constexpr (sub == SUB_INPROJ) {
            { SchedZ Sz{wl + W_Z, (const char*)XN, F.vcu}; EpiZ Ez{ZT}; gemm_phase<EpiZ, SchedZ, 1, false>(F.lds, D, Sz, Ez); }
            { SchedQKV Sq{(const char*)XN, wl + W_QKV, F.vcu, l == 0 ? 1 : 0}; EpiQKV Eq{Qb, Kb, Vb, rope}; gemm_phase<EpiQKV, SchedQKV, 0, false>(F.lds, D, Sq, Eq); }
            if (l == 0) { SchedZc Sc{wl + W_Z, (const char*)XN, F.vcu}; EpiZc Ec{ZTc}; gemm_phase<EpiZc, SchedZc, 0, false>(F.lds, D, Sc, Ec); }
        }
        else if constexpr (sub == SUB_MIX) {
            const float* sinkl = c.sink + l * 8;
            for (int i = 0; i < 2; ++i) { const int uid = F.vcu * 2 + i; const int b = uid >> 7, kvh = (uid >> 6) & 1, qb = uid & 63;
                att::attn_unit(F.lds, Qb, Kb, Vb, AO, sinkl, b * S + 64 * qb, kvh, MLAT + b * CL, b * S, qb); }
            if (l == 0 && (F.vcu & 7) == 0) { const int e = F.vcu >> 3; const int b = e >> 3, kvh = (e >> 2) & 1, qb = e & 3;
                att::attn_unit(F.lds, Qb, Kb, Vb, AO, sinkl, MLAT + b * CL + 64 * qb, kvh, MLAT + b * CL, -1, qb); }
            fft::fft_load_tables(F.lds, tabs + TAB_FFT); __syncthreads();
            fft::fft_unit(F.lds, ZT, AO, F.vcu >> 6, F.vcu & 63);
            if (l == 0) { SchedFc Sf{(const char*)(tabs + TAB_DC), (const char*)ZTc, F.vcu}; EpiBf16 Ef{AO, D}; gemm_phase<EpiBf16, SchedFc, 0, false>(F.lds, 512, Sf, Ef); }
        }
        else if constexpr (sub == SUB_OUT) {
            SchedMN Sm{(const char*)AO, wl + W_O, D, nMt, 4, F.G, (int)blockIdx.x}; EpiF32 Ey{Y, D};
            gemm_phase<EpiF32, SchedMN, 0, false>(F.lds, D, Sm, Ey);
        }
        else if constexpr (sub == SUB_POST1 || sub == SUB_POST2) {
            const bool p1 = sub == SUB_POST1; const int nrows = nMt * 256;
            for (int m = gw; m < nrows; m += NGW) {
                const bool lat = m < MLAT; const int r = lat ? (m >> 12) : 4; const float* ml = mod + (size_t)(l * 5 + r) * 6144;
                float* xo = lat ? out + (size_t)m * D : XC + (size_t)(m - MLAT) * D;
                const float* xi = (p1 && l == 0) ? (lat ? x_in + (size_t)m * D : ctx_in + (size_t)(m - MLAT) * D) : xo;
                if (p1) post_row(Y + (size_t)m * D, xi, xo, npo + l * D, ml + 2 * 1024, true, npf + l * D, ml + 3 * 1024, ml + 4 * 1024, XN + (size_t)m * D, F.lane);
                else { const float* ml1 = mod + (size_t)(5 + r) * 6144;
                    post_row(Y + (size_t)m * D, xi, xo, npof + l * D, ml + 5 * 1024, l == 0, npm + D, ml1, ml1 + 1024, XN + (size_t)m * D, F.lane); }
            }
        }
        else if constexpr (sub == SUB_GATEUP) {
            SchedMN Sm{(const char*)XN, wl + W_GU, D, nMt, NGU / 256, F.G, (int)blockIdx.x}; EpiSwiGLU Eg{HID};
            gemm_phase<EpiSwiGLU, SchedMN, 0, true>(F.lds, D, Sm, Eg);
        }
        else if constexpr (sub == SUB_DOWN) {
            SchedMN Sm{(const char*)HID, wl + W_D, FF, nMt, 4, F.G, (int)blockIdx.x}; EpiF32 Ey{Y, D};
            gemm_phase<EpiF32, SchedMN, 0, false>(F.lds, FF, Sm, Ey);
        }
}

__global__ void __launch_bounds__(NWAVES * 64, 2) mk_fwd(Args args) {
    extern __shared__ __attribute__((aligned(16))) unsigned char lds_raw[];
    Frame F; F.lds = (LAS unsigned char*)lds_raw; F.tid = threadIdx.x; F.lane = F.tid & 63; F.wave = __builtin_amdgcn_readfirstlane(F.tid >> 6);
    F.G = gridDim.x; { const int bx = blockIdx.x; F.vcu = (F.G % 8 == 0) ? (bx % 8) * (F.G / 8) + bx / 8 : bx; }
    unsigned char* ws = args.ws;
    const float* x_in = args.in[0]; const float* c_in = args.in[1]; const float* ctx_in = args.in[2]; const float* c_ctx = args.in[3];
    const float* w_ada = args.in[4]; const float* b_ada = args.in[5]; const float* npm = args.in[6]; const float* npo = args.in[7]; const float* npf = args.in[8]; const float* npof = args.in[9];
    const float* w_in = args.in[10]; const float* w_out = args.in[11]; const float* w_four = args.in[12];
    const float* w_gate = args.in[14]; const float* w_up = args.in[15]; const float* w_down = args.in[16];
    float* out = args.out;
    float* mod = (float*)(ws + WS_CTL + CTL_MOD_OFF);
    unsigned char* tabs = ws + WS_TAB; float* rope = (float*)(tabs + TAB_ROPE);
    bf16_t* XN = (bf16_t*)(ws + WS_XN); bf16_t* Qb = (bf16_t*)(ws + WS_Q); bf16_t* Kb = (bf16_t*)(ws + WS_K); bf16_t* Vb = (bf16_t*)(ws + WS_V);
    bf16_t* ZT = (bf16_t*)(ws + WS_ZT); bf16_t* ZTc = (bf16_t*)(ws + WS_ZTC); bf16_t* AO = (bf16_t*)(ws + WS_AO); bf16_t* HID = (bf16_t*)(ws + WS_HID);
    float* Y = (float*)(ws + WS_Y); float* XC = (float*)(ws + WS_XC);
    const int lo = args.ph_lo, hi = args.ph_hi;
    const int gw = F.vcu * NWAVES + F.wave, NGW = F.G * NWAVES;
    Ctx c; c.F = F; c.ws = ws; c.in = nullptr; c.out = out; c.x_in = x_in; c.c_in = c_in; c.ctx_in = ctx_in; c.c_ctx = c_ctx; c.w_ada = w_ada; c.b_ada = b_ada; c.npm = npm; c.npo = npo; c.npf = npf; c.npof = npof;
    c.w_in = w_in; c.w_out = w_out; c.w_four = w_four; c.w_gate = w_gate; c.w_up = w_up; c.w_down = w_down; c.sink = args.in[13]; c.mod = mod; c.rope = rope; c.Y = Y; c.XC = XC; c.tabs = tabs;
    c.XN = XN; c.Qb = Qb; c.Kb = Kb; c.Vb = Vb; c.ZT = ZT; c.ZTc = ZTc; c.AO = AO; c.HID = HID; c.gw = gw; c.NGW = NGW; c.p0sel = args.pad;
    for (int u = F.tid; u < (LDS_BYTES - LDSCTL_OFF) / 4; u += NWAVES * 64) ((LAS unsigned*)(F.lds + LDSCTL_OFF))[u] = 0u;
    __syncthreads();
    XcdBarrier bar; bar.bar = (unsigned*)(ws + WS_CTL) + CW_BAR; bar.x = 0; bar.st = nullptr;
    if (hi - lo > 1) bar = xcd_barrier_post((unsigned*)(ws + WS_CTL) + CW_BAR, (volatile LAS unsigned*)(F.lds + MISC_OFF) + 8);

#define MK_PHASE(PH) if (lo <= (PH) && (PH) < hi) { run_phase<PH>(c); if ((PH) + 1 < hi) xcd_barrier(bar); }
    MK_PHASE(0)
    MK_PHASE(1)
    MK_PHASE(2)
    MK_PHASE(3)
    MK_PHASE(4)
    MK_PHASE(5)
    MK_PHASE(6)
    MK_PHASE(7)
    MK_PHASE(8)
    MK_PHASE(9)
    MK_PHASE(10)
    MK_PHASE(11)
    MK_PHASE(12)
    MK_PHASE(13)
    MK_PHASE(14)
    MK_PHASE(15)
#undef MK_PHASE
}
}

extern "C" void kernel_launch(void* const* d_in, const int* in_sizes, int n_in, void* d_out, int out_size, void* d_ws, size_t ws_size, hipStream_t stream) {
    static int grid = 0;
    if (grid == 0) {
        int dev = 0, cus = 0, per_cu = 0;
        if (hipGetDevice(&dev) != hipSuccess || hipDeviceGetAttribute(&cus, hipDeviceAttributeMultiprocessorCount, dev) != hipSuccess) { grid = -1; }
        else if (hipFuncSetAttribute((const void*)mk::mk_fwd, hipFuncAttributeMaxDynamicSharedMemorySize, mk::LDS_BYTES) != hipSuccess) { grid = -1; }
        else { if (hipOccupancyMaxActiveBlocksPerMultiprocessor(&per_cu, (const void*)mk::mk_fwd, mk::NWAVES * 64, mk::LDS_BYTES) != hipSuccess) per_cu = 0;
               (void)hipGetLastError();
               grid = (per_cu >= 1 && cus >= 256) ? 256 : -1; }
        if (grid < 0) fprintf(stderr, "kernel_launch: needs 256 CUs with one resident 512-thread workgroup each (cus %d, per_cu %d); nothing launched\n", cus, per_cu);
    }
    if (grid < 0) return;
    if (hipMemsetAsync((char*)d_ws + mk::WS_CTL, 0, mk::CTL_ZERO_BYTES, stream) != hipSuccess) return;
    mk::Args a{};
    for (int i = 0; i < 17; ++i) a.in[i] = (const float*)d_in[i];
    a.out = (float*)d_out; a.ws = (unsigned char*)d_ws; a.xsrc = nullptr; a.xcsrc = nullptr; a.layer = 0; a.pad = 0;
#ifndef MK_N_LAUNCHES
#define MK_N_LAUNCHES 1
#endif
#if MK_N_LAUNCHES == 1
    a.ph_lo = 0; a.ph_hi = mk::N_PHASES;
    hipLaunchKernelGGL(mk::mk_fwd, dim3(grid), dim3(mk::NWAVES * 64), mk::LDS_BYTES, stream, a);
#else
#ifndef MK_DUPMASK
#define MK_DUPMASK 0
#endif
#ifndef MK_P0PROBE
#define MK_P0PROBE 0
#endif
    for (int ph = 0; ph < mk::N_PHASES; ++ph) { const int reps = ((MK_DUPMASK >> ph) & 1) ? 3 : 1;
        if (ph == 0 && MK_P0PROBE != 0) {
            a.ph_lo = 0; a.ph_hi = 1; a.pad = 0; hipLaunchKernelGGL(mk::mk_fwd, dim3(grid), dim3(mk::NWAVES * 64), mk::LDS_BYTES, stream, a);
            for (int r = 0; r < 2; ++r) { if (MK_P0PROBE == 4) { (void)hipMemsetAsync((char*)d_ws + mk::WS_CTL, 0, mk::CTL_ZERO_BYTES, stream); } a.pad = MK_P0PROBE; hipLaunchKernelGGL(mk::mk_fwd, dim3(grid), dim3(mk::NWAVES * 64), mk::LDS_BYTES, stream, a); }
            a.pad = 0; continue; }
        for (int r = 0; r < reps; ++r) { if (ph == 0 && r > 0) (void)hipMemsetAsync((char*)d_ws + mk::WS_CTL, 0, mk::CTL_ZERO_BYTES, stream); a.ph_lo = ph; a.ph_hi = ph + 1; hipLaunchKernelGGL(mk::mk_fwd, dim3(grid), dim3(mk::NWAVES * 64), mk::LDS_BYTES, stream, a); } }
#endif
}
```
